# Optimizing an MI355X kernel written in HIP

```python
import math
import jax, jax.numpy as jnp
from jax import lax
import numpy as np

D_MODEL = 1024
BATCH = 8
SEQ = 4096
DEPTH = 1

MEM_LEN = 256
EPS = 1e-6
ROPE_THETA = 10000.0
A_HEADS = 8
A_HEAD_DIM = 64
A_WIDTH = A_HEADS * A_HEAD_DIM
MOBA_BLOCK = 256
MOBA_TOPK = 3
Q_BLOCK = 128
R_HEADS = 4
R_QK_DIM = 128
R_V_DIM = 256
R_QK_WIDTH = R_HEADS * R_QK_DIM
R_V_WIDTH = R_HEADS * R_V_DIM
R_CHUNK = 128
X_HEADS = 4
X_HEAD_DIM = D_MODEL // X_HEADS
D_FF = -(-8 * D_MODEL // (3 * 256)) * 256
SPLIT_SIZES = (A_WIDTH, A_WIDTH, A_WIDTH, R_QK_WIDTH, R_QK_WIDTH, R_V_WIDTH, R_V_WIDTH, D_MODEL, D_MODEL)
IN_COLS = sum(SPLIT_SIZES)

kernel_name = "moba_retention_gated_hybrid"


def rms_norm(x, g):
    xf = x.astype(jnp.float32)
    y = xf * lax.rsqrt(jnp.mean(xf * xf, axis=-1, keepdims=True) + EPS)
    return (y * g.astype(jnp.float32)).astype(x.dtype)


def rotary(x, pos):
    d = x.shape[-1]
    inv = ROPE_THETA ** (-jnp.arange(0, d, 2, dtype=jnp.float32) / d)
    ang = pos.astype(jnp.float32)[:, None] * inv[None, :]
    cos, sin = jnp.cos(ang), jnp.sin(ang)
    xf = x.astype(jnp.float32)
    x1, x2 = xf[..., : d // 2], xf[..., d // 2:]
    return jnp.concatenate([x1 * cos - x2 * sin, x2 * cos + x1 * sin], axis=-1).astype(x.dtype)


def to_heads(t, n_heads, head_dim):
    b, s, _ = t.shape
    return t.reshape(b, s, n_heads, head_dim).transpose(0, 2, 1, 3)


def from_heads(t):
    b, h, s, d = t.shape
    return t.transpose(0, 2, 1, 3).reshape(b, s, h * d)


def moba_attention(q, k, v):
    B, H, S, dh = q.shape
    nb = -(-S // MOBA_BLOCK)
    pad = nb * MOBA_BLOCK - S
    kp = jnp.pad(k, ((0, 0), (0, 0), (0, pad), (0, 0)))
    vp = jnp.pad(v, ((0, 0), (0, 0), (0, pad), (0, 0)))
    kb = kp.reshape(B, H, nb, MOBA_BLOCK, dh)
    vb = vp.reshape(B, H, nb, MOBA_BLOCK, dh)
    n_sel = min(MOBA_TOPK, nb - 1)
    scale = dh ** -0.5
    nqc = S // Q_BLOCK
    pos = jnp.arange(S)
    q_blk = pos // MOBA_BLOCK

    qc = q.reshape(B, H, nqc, Q_BLOCK, dh).transpose(0, 2, 1, 3, 4).reshape(B * nqc, H, Q_BLOCK, dh)
    if n_sel > 0:
        kmean = jnp.mean(kb, axis=3, dtype=jnp.float32)
        bscore = jnp.einsum('bhsd,bhnd->bhsn', q.astype(jnp.float32), kmean)
        past = jnp.arange(nb)[None, :] < q_blk[:, None]
        bscore = jnp.where(past[None, None], bscore, -jnp.inf)
        _, sel = lax.top_k(bscore, n_sel)
        selc = sel.reshape(B, H, nqc, Q_BLOCK, n_sel).transpose(0, 2, 1, 3, 4).reshape(B * nqc, H, Q_BLOCK, n_sel)
    else:
        selc = jnp.zeros((B * nqc, H, Q_BLOCK, 0), jnp.int32)
    hidx = jnp.arange(H)[:, None, None]

    def step(args):
        sid, qb, selb = args
        bi = sid // nqc
        ci = sid % nqc
        kb_b = kb[bi]
        vb_b = vb[bi]
        qpos = ci * Q_BLOCK + jnp.arange(Q_BLOCK)
        own = (ci * Q_BLOCK) // MOBA_BLOCK
        k_own = lax.dynamic_index_in_dim(kb_b, own, axis=1, keepdims=False)
        v_own = lax.dynamic_index_in_dim(vb_b, own, axis=1, keepdims=False)
        kpos_own = own * MOBA_BLOCK + jnp.arange(MOBA_BLOCK)
        s_own = jnp.einsum('hqd,hkd->hqk', qb, k_own, preferred_element_type=jnp.float32) * scale
        s_own = jnp.where((kpos_own[None, :] <= qpos[:, None])[None], s_own, -jnp.inf)
        if n_sel > 0:
            k_sel = kb_b[hidx, selb]
            v_sel = vb_b[hidx, selb]
            s_sel = jnp.einsum('hqd,hqrkd->hqrk', qb, k_sel, preferred_element_type=jnp.float32) * scale
            valid = jnp.arange(n_sel)[None, :] < (qpos // MOBA_BLOCK)[:, None]
            s_sel = jnp.where(valid[None, :, :, None], s_sel, -jnp.inf)
            s = jnp.concatenate([s_sel.reshape(H, Q_BLOCK, n_sel * MOBA_BLOCK), s_own], axis=-1)
            p = jax.nn.softmax(s, axis=-1).astype(v.dtype)
            p_sel = p[..., : n_sel * MOBA_BLOCK].reshape(H, Q_BLOCK, n_sel, MOBA_BLOCK)
            p_own = p[..., n_sel * MOBA_BLOCK:]
            o = (jnp.einsum('hqrk,hqrkd->hqd', p_sel, v_sel)
                 + jnp.einsum('hqk,hkd->hqd', p_own, v_own))
        else:
            p_own = jax.nn.softmax(s_own, axis=-1).astype(v.dtype)
            o = jnp.einsum('hqk,hkd->hqd', p_own, v_own)
        return o.astype(q.dtype)

    out = lax.map(step, (jnp.arange(B * nqc), qc, selc))
    return out.reshape(B, nqc, H, Q_BLOCK, dh).transpose(0, 2, 1, 3, 4).reshape(B, H, S, dh)


def retention(q, k, v):
    B, H, S, dk = q.shape
    dv = v.shape[-1]
    C = R_CHUNK
    n = S // C
    q = q.astype(jnp.float32)
    k = k.astype(jnp.float32)
    v = v.astype(jnp.float32)
    log_g = jnp.log(1.0 - jnp.exp2(-5.0 - jnp.arange(H, dtype=jnp.float32)))
    i = jnp.arange(C, dtype=jnp.float32)
    diff = i[:, None] - i[None, :]
    dmask = jnp.where(diff >= 0, jnp.exp(log_g[:, None, None] * jnp.maximum(diff, 0.0)), 0.0)
    q_dec = jnp.exp(log_g[:, None] * (i + 1.0))
    k_dec = jnp.exp(log_g[:, None] * (C - 1.0 - i))
    chunk_dec = jnp.exp(log_g * C)

    qc = q.reshape(B, H, n, C, dk)
    kc = k.reshape(B, H, n, C, dk)
    vc = v.reshape(B, H, n, C, dv)
    att = jnp.einsum('bhnid,bhnjd->bhnij', qc, kc) * dmask[None, :, None]
    inner = jnp.einsum('bhnij,bhnje->bhnie', att, vc)
    kv = jnp.einsum('bhnjd,bhnje->bhnde', kc * k_dec[None, :, None, :, None], vc)

    def scan_fn(state, kv_n):
        return chunk_dec[None, :, None, None] * state + kv_n, state

    _, prev = lax.scan(scan_fn, jnp.zeros((B, H, dk, dv), jnp.float32), kv.transpose(2, 0, 1, 3, 4))
    prev = prev.transpose(1, 2, 0, 3, 4)
    cross = jnp.einsum('bhnid,bhnde->bhnie', qc * q_dec[None, :, None, :, None], prev)
    return (inner + cross).reshape(B, H, S, dv)


def head_group_norm(y):
    mu = jnp.mean(y, axis=-1, keepdims=True)
    var = jnp.mean(jnp.square(y - mu), axis=-1, keepdims=True)
    return (y - mu) * lax.rsqrt(var + EPS)


def cross_attention(h, m, w_q, w_kv, w_o):
    q = to_heads(h @ w_q, X_HEADS, X_HEAD_DIM)
    kv = m @ w_kv
    k = to_heads(kv[..., :D_MODEL], X_HEADS, X_HEAD_DIM)
    v = to_heads(kv[..., D_MODEL:], X_HEADS, X_HEAD_DIM)
    s = jnp.einsum('bhsd,bhmd->bhsm', q, k, preferred_element_type=jnp.float32) * (X_HEAD_DIM ** -0.5)
    p = jax.nn.softmax(s, axis=-1).astype(v.dtype)
    o = jnp.einsum('bhsm,bhmd->bhsd', p, v)
    return from_heads(o) @ w_o


def setup_inputs(seed: int = 0) -> dict:
    key = jax.random.key(seed)
    ks = jax.random.split(key, 20)

    def w(k, shape, fan_in):
        return jax.random.normal(k, shape, jnp.float32) * (fan_in ** -0.5)

    def gain(k, shape):
        return 1.0 + 0.02 * jax.random.normal(k, shape, jnp.float32)

    return {
        "x": jax.random.normal(ks[0], (BATCH, SEQ, D_MODEL), jnp.float32),
        "mem": jax.random.normal(ks[1], (BATCH, MEM_LEN, D_MODEL), jnp.float32),
        "norm_mix": gain(ks[2], (DEPTH, D_MODEL)),
        "w_in": w(ks[3], (DEPTH, D_MODEL, IN_COLS), D_MODEL),
        "w_branch_a": w(ks[4], (DEPTH, A_WIDTH, D_MODEL), A_WIDTH),
        "w_branch_b": w(ks[5], (DEPTH, R_V_WIDTH, D_MODEL), R_V_WIDTH),
        "w_out": w(ks[6], (DEPTH, D_MODEL, D_MODEL), D_MODEL),
        "norm_cross": gain(ks[7], (DEPTH, D_MODEL)),
        "norm_mem": gain(ks[8], (DEPTH, D_MODEL)),
        "w_xq": w(ks[9], (DEPTH, D_MODEL, D_MODEL), D_MODEL),
        "w_xkv": w(ks[10], (DEPTH, D_MODEL, 2 * D_MODEL), D_MODEL),
        "w_xo": w(ks[11], (DEPTH, D_MODEL, D_MODEL), D_MODEL),
        "norm_ffn": gain(ks[12], (DEPTH, D_MODEL)),
        "w_gate": w(ks[13], (DEPTH, D_MODEL, D_FF), D_MODEL),
        "w_up": w(ks[14], (DEPTH, D_MODEL, D_FF), D_MODEL),
        "w_down": w(ks[15], (DEPTH, D_FF, D_MODEL), D_FF),
        "norm_final": gain(ks[16], (D_MODEL,)),
    }


def reference(x, mem, norm_mix, w_in, w_branch_a, w_branch_b, w_out, norm_cross, norm_mem,
              w_xq, w_xkv, w_xo, norm_ffn, w_gate, w_up, w_down, norm_final):
    B, S, _ = x.shape
    pos = jnp.arange(S)
    split_points = [int(p) for p in np.cumsum(SPLIT_SIZES)[:-1]]
    for l in range(DEPTH):
        h = rms_norm(x, norm_mix[l])
        proj = h @ w_in[l]
        aq, ak, av, rq, rk, rv, rg, ga, gb = jnp.split(proj, split_points, axis=-1)

        aq = rotary(to_heads(aq, A_HEADS, A_HEAD_DIM), pos)
        ak = rotary(to_heads(ak, A_HEADS, A_HEAD_DIM), pos)
        av = to_heads(av, A_HEADS, A_HEAD_DIM)
        y_a = from_heads(moba_attention(aq, ak, av))

        rq = rotary(to_heads(rq, R_HEADS, R_QK_DIM), pos)
        rk = rotary(to_heads(rk, R_HEADS, R_QK_DIM), pos) * (R_QK_DIM ** -0.5)
        rv = to_heads(rv, R_HEADS, R_V_DIM)
        y_r = head_group_norm(retention(rq, rk, rv))
        y_b = from_heads(y_r).astype(x.dtype) * jax.nn.silu(rg)

        merged = (jax.nn.sigmoid(ga) * (y_a @ w_branch_a[l])
                  + jax.nn.sigmoid(gb) * (y_b @ w_branch_b[l]))
        x = x + merged @ w_out[l]

        x = x + cross_attention(rms_norm(x, norm_cross[l]), rms_norm(mem, norm_mem[l]),
                                w_xq[l], w_xkv[l], w_xo[l])

        h = rms_norm(x, norm_ffn[l])
        x = x + (jax.nn.silu(h @ w_gate[l]) * (h @ w_up[l])) @ w_down[l]
    return rms_norm(x, norm_final)
```

```cpp
#include <hip/hip_runtime.h>
#include <cstdio>
#include <cstdint>
namespace pg8 {
#define PG8_LAS __attribute__((address_space(3)))
typedef unsigned short bf16_t;
typedef short bf16x8 __attribute__((ext_vector_type(8)));
typedef float f32x4 __attribute__((ext_vector_type(4)));
typedef unsigned u32x4 __attribute__((ext_vector_type(4)));
constexpr int BM = 256, BK = 64, HALF = 128, HTB = HALF * BK * 2  , STAGE_BYTES = 8 * HTB, NXCD = 8, WGM = 8;

__host__ __device__ __forceinline__ int lds_byte(int r, int c) { const int st = (r >> 4) * 2 + (c >> 5), rr = r & 15, cc = c & 31, ob = rr * 64 + cc * 2; return st * 1024 + (ob ^ (((ob >> 9) & 1) << 5)); }
__host__ __device__ __forceinline__ void stage_rc(int b, int& R, int& C) { const int st = b / 1024, sb = b % 1024, swz = sb ^ (((sb >> 9) & 1) << 5); R = (st >> 1) * 16 + swz / 64; C = (st & 1) * 32 + (swz % 64) / 2; }
__host__ __device__ __forceinline__ int perm32(int rho) { const int n = rho >> 4, i = rho & 15; return 8 * (i >> 2) + 4 * n + (i & 3); }

struct Unit { int pm, pn; };
struct Gemm { const bf16_t* A; const bf16_t* Bt; int M, N, K; };

struct StaticOrder {
    int nM, nN, nwg, G, c;
    __host__ __device__ void init(int M, int N, int G_, int c_) { nM = M / BM; nN = N / BM; nwg = nM * nN; G = G_; c = c_; }
    __host__ __device__ bool next(int i, Unit& u) const {
        const long L = (long)i * G + c; if (L >= nwg) return false;
        int wgid = (int)L; { const int q = nwg / NXCD, r = nwg % NXCD, xcd = wgid % NXCD, off = wgid / NXCD; wgid = (xcd < r ? xcd * (q + 1) : r * (q + 1) + (xcd - r) * q) + off; }
        const int nig = WGM * nN, gid = wgid / nig, fm = gid * WGM, gsz = (nM - fm) < WGM ? (nM - fm) : WGM;
        u.pm = fm + ((wgid % nig) % gsz); u.pn = (wgid % nig) / gsz; return true;
    }
    __device__ __forceinline__ void a_ready(const Unit&) const {}
    __device__ __forceinline__ void done(const Unit&) const {}
};


typedef unsigned u32x2 __attribute__((ext_vector_type(2)));
__device__ __forceinline__ unsigned f2bf(float f) { unsigned u = __builtin_bit_cast(unsigned, f); return (u + 0x7fffu + ((u >> 16) & 1u)) >> 16; }
__device__ __forceinline__ unsigned pk2(float lo, float hi) { return f2bf(lo) | (f2bf(hi) << 16); }
__device__ __forceinline__ float bflo(unsigned w) { return __builtin_bit_cast(float, w << 16); }
__device__ __forceinline__ float bfhi(unsigned w) { return __builtin_bit_cast(float, w & 0xffff0000u); }
__device__ __forceinline__ u32x2 pk4(f32x4 v) { u32x2 w; w.x = pk2(v[0], v[1]); w.y = pk2(v[2], v[3]); return w; }
__device__ __forceinline__ f32x4 unpk4(u32x2 w) { return (f32x4){bflo(w.x), bfhi(w.x), bflo(w.y), bfhi(w.y)}; }
__device__ __forceinline__ float lg2gamma(int h) { return h == 0 ? -0.04580368961312479f : (h == 1 ? -0.02272007650008353f : (h == 2 ? -0.011315313227834146f : -0.005646563141142063f)); }
__device__ __forceinline__ float sigmoidf_(float v) { return 1.0f / (1.0f + __expf(-v)); }
constexpr int SEQ_ = 4096, DM_ = 1024;

struct EpiProj {
    static constexpr bool PERM = false, AFTER_DRAIN = false; static constexpr int MID_T = 0;
    bf16_t *YAB, *AK, *AVT, *RQ, *RK, *RKT, *RVT, *RG, *GR, *GS; float* KMEAN; const float* T64; const float* T128;
    __device__ __forceinline__ void mid(f32x4 (&)[2][2][4][2], const Unit&, int, int, int, int) const {}
    __device__ __forceinline__ void operator()(const f32x4 (&acc)[2][2][4][2], const Unit& u, int wr, int wc, int fr, int fq) const {
        const int pn = u.pn, rowb = u.pm * BM + wr * 64 + fr, b = u.pm >> 4;
        if (pn < 4 || (pn >= 6 && pn < 10)) {
            const bool is64 = pn < 4; const int rt = pn & 1, kind = is64 ? (pn >> 1) : (((pn - 6) >> 1) + 2);
            const int f0 = (is64 ? 16 * (wc & 1) : 16 * wc) + 4 * fq;
            f32x4 ks[2][2];
#pragma unroll
            for (int bj = 0; bj < 2; ++bj) { ks[bj][0] = (f32x4){0.f, 0.f, 0.f, 0.f}; ks[bj][1] = (f32x4){0.f, 0.f, 0.f, 0.f}; }
#pragma unroll
            for (int ai = 0; ai < 2; ++ai)
#pragma unroll
                for (int m = 0; m < 4; ++m) {
                    const int row = rowb + ai * HALF + m * 16, pos = row & (SEQ_ - 1);
                    const float* tp = is64 ? (T64 + ((size_t)pos * 32 + f0) * 2) : (T128 + ((size_t)pos * 64 + f0) * 2);
                    const f32x4 cs0 = *(const f32x4*)tp, cs1 = *(const f32x4*)(tp + 4);
                    const float co[4] = {cs0[0], cs0[2], cs1[0], cs1[2]}, si[4] = {cs0[1], cs0[3], cs1[1], cs1[3]};
#pragma unroll
                    for (int bj = 0; bj < 2; ++bj) {
                        const f32x4 x1 = acc[ai][bj][m][0], x2 = acc[ai][bj][m][1]; f32x4 y1, y2;
#pragma unroll
                        for (int i = 0; i < 4; ++i) { y1[i] = x1[i] * co[i] - x2[i] * si[i]; y2[i] = x2[i] * co[i] + x1[i] * si[i]; }
                        const int rc = rt * 256 + bj * HALF + wc * 32 + 4 * fq;
                        bf16_t* dst = (kind == 0) ? (YAB + (size_t)row * 1536 + rc) : ((kind == 1 ? AK : (kind == 2 ? RQ : RK)) + (size_t)row * 512 + rc);
                        *(u32x2*)dst = pk4(y1); *(u32x2*)(dst + 16) = pk4(y2);
                        if (kind == 1) { ks[bj][0] += y1; ks[bj][1] += y2; }
                        if (kind == 3) {
                            const int hh = rt * 2 + bj; const float kd = __builtin_amdgcn_exp2f((float)(127 - (pos & 127)) * lg2gamma(hh));
                            bf16_t* tb = RKT + ((size_t)((b * 4 + hh) * 128 + wc * 32 + 4 * fq)) * SEQ_ + pos;
#pragma unroll
                            for (int i = 0; i < 4; ++i) { tb[(size_t)i * SEQ_] = (bf16_t)f2bf(y1[i] * kd); tb[(size_t)(16 + i) * SEQ_] = (bf16_t)f2bf(y2[i] * kd); }
                        }
                    }
                }
            if (kind == 1) {
                const int blk = u.pm & 15;
#pragma unroll
                for (int bj = 0; bj < 2; ++bj)
#pragma unroll
                    for (int n = 0; n < 2; ++n)
#pragma unroll
                        for (int i = 0; i < 4; ++i) {
                            float s = ks[bj][n][i];
                            s += __shfl_xor(s, 1); s += __shfl_xor(s, 2); s += __shfl_xor(s, 4); s += __shfl_xor(s, 8);
                            if (fr == 0) atomicAdd(KMEAN + (size_t)(b * 16 + blk) * 512 + rt * 256 + bj * HALF + wc * 32 + 16 * n + 4 * fq + i, s);
                        }
            }
        } else if (pn < 6 || (pn >= 10 && pn < 14)) {
            const bool isa = pn < 6; const int rt = isa ? pn - 4 : pn - 10;
#pragma unroll
            for (int ai = 0; ai < 2; ++ai)
#pragma unroll
                for (int m = 0; m < 4; ++m) {
                    const int row = rowb + ai * HALF + m * 16, pos = row & (SEQ_ - 1);
#pragma unroll
                    for (int bj = 0; bj < 2; ++bj)
#pragma unroll
                        for (int n = 0; n < 2; ++n) {
                            const int rc = rt * 256 + bj * HALF + wc * 32 + 16 * n + 4 * fq;
                            bf16_t* tb = isa ? (AVT + ((size_t)((b * 8 + (rc >> 6)) * 64 + (rc & 63))) * SEQ_ + pos) : (RVT + ((size_t)((b * 4 + (rc >> 8)) * 256 + (rc & 255))) * SEQ_ + pos);
                            const f32x4 v = acc[ai][bj][m][n];
#pragma unroll
                            for (int i = 0; i < 4; ++i) tb[(size_t)i * SEQ_] = (bf16_t)f2bf(v[i]);
                        }
                }
        } else if (pn < 18) {
            const int rt = pn - 14;
#pragma unroll
            for (int ai = 0; ai < 2; ++ai)
#pragma unroll
                for (int m = 0; m < 4; ++m) {
                    const int row = rowb + ai * HALF + m * 16;
#pragma unroll
                    for (int bj = 0; bj < 2; ++bj)
#pragma unroll
                        for (int n = 0; n < 2; ++n) {
                            const int rc = rt * 256 + bj * HALF + wc * 32 + 16 * n + 4 * fq; f32x4 v = acc[ai][bj][m][n];
#pragma unroll
                            for (int i = 0; i < 4; ++i) v[i] = v[i] * sigmoidf_(v[i]);
                            *(u32x2*)(RG + (size_t)row * 1024 + rc) = pk4(v);
                        }
                }
        } else {
            const int q = pn - 18;
#pragma unroll
            for (int ai = 0; ai < 2; ++ai)
#pragma unroll
                for (int m = 0; m < 4; ++m) {
                    const int row = rowb + ai * HALF + m * 16;
#pragma unroll
                    for (int bj = 0; bj < 2; ++bj) {
                        const int cg = 128 * q + 64 * bj + 16 * wc + 4 * fq; const f32x4 ga = acc[ai][bj][m][0], gb = acc[ai][bj][m][1]; f32x4 rr, sb;
#pragma unroll
                        for (int i = 0; i < 4; ++i) { const float ea = __expf(-ga[i]), eb = __expf(-gb[i]); sb[i] = 1.0f / (1.0f + eb); rr[i] = (1.0f + eb) / (1.0f + ea); }
                        *(u32x2*)(GR + (size_t)row * 1024 + cg) = pk4(rr); *(u32x2*)(GS + (size_t)row * 1024 + cg) = pk4(sb);
                    }
                }
        }
    }
};

struct EpiKVX {
    static constexpr bool PERM = false, AFTER_DRAIN = false; static constexpr int MID_T = 0;
    bf16_t *KX, *VXT;
    __device__ __forceinline__ void mid(f32x4 (&)[2][2][4][2], const Unit&, int, int, int, int) const {}
    __device__ __forceinline__ void operator()(const f32x4 (&acc)[2][2][4][2], const Unit& u, int wr, int wc, int fr, int fq) const {
        const int pn = u.pn, b = u.pm;
#pragma unroll
        for (int ai = 0; ai < 2; ++ai)
#pragma unroll
            for (int m = 0; m < 4; ++m) {
                const int mt = ai * HALF + wr * 64 + m * 16 + fr;
#pragma unroll
                for (int bj = 0; bj < 2; ++bj)
#pragma unroll
                    for (int n = 0; n < 2; ++n) {
                        const int cc = bj * HALF + wc * 32 + 16 * n + 4 * fq; const f32x4 v = acc[ai][bj][m][n];
                        if (pn < 4) *(u32x2*)(KX + (size_t)(b * 256 + mt) * 1024 + pn * 256 + cc) = pk4(v);
                        else { bf16_t* tb = VXT + ((size_t)((b * 4 + (pn - 4)) * 256 + cc)) * 256 + mt;
#pragma unroll
                            for (int i = 0; i < 4; ++i) tb[(size_t)i * 256] = (bf16_t)f2bf(v[i]); }
                    }
            }
    }
};

struct EpiMerge {
    static constexpr bool PERM = false, AFTER_DRAIN = false; static constexpr int MID_T = 8;
    const bf16_t *GR, *GS; bf16_t* OUT;
    __device__ __forceinline__ void mid(f32x4 (&acc)[2][2][4][2], const Unit& u, int wr, int wc, int fr, int fq) const {
#pragma unroll
        for (int ai = 0; ai < 2; ++ai)
#pragma unroll
            for (int m = 0; m < 4; ++m) {
                const int row = u.pm * BM + ai * HALF + wr * 64 + m * 16 + fr;
#pragma unroll
                for (int bj = 0; bj < 2; ++bj)
#pragma unroll
                    for (int n = 0; n < 2; ++n) { const int c = u.pn * BM + bj * HALF + wc * 32 + 16 * n + 4 * fq; acc[ai][bj][m][n] *= unpk4(*(const u32x2*)(GR + (size_t)row * 1024 + c)); }
            }
    }
    __device__ __forceinline__ void operator()(const f32x4 (&acc)[2][2][4][2], const Unit& u, int wr, int wc, int fr, int fq) const {
#pragma unroll
        for (int ai = 0; ai < 2; ++ai)
#pragma unroll
            for (int m = 0; m < 4; ++m) {
                const int row = u.pm * BM + ai * HALF + wr * 64 + m * 16 + fr;
#pragma unroll
                for (int bj = 0; bj < 2; ++bj)
#pragma unroll
                    for (int n = 0; n < 2; ++n) { const int c = u.pn * BM + bj * HALF + wc * 32 + 16 * n + 4 * fq;
                        *(u32x2*)(OUT + (size_t)row * 1024 + c) = pk4(acc[ai][bj][m][n] * unpk4(*(const u32x2*)(GS + (size_t)row * 1024 + c))); }
            }
    }
};

template <bool WRITE_XB> struct EpiResid {
    static constexpr bool PERM = false, AFTER_DRAIN = false; static constexpr int MID_T = 0;
    const float* base; float* out; bf16_t* XB; const float* gain; float* SSQ;
    __device__ __forceinline__ void mid(f32x4 (&)[2][2][4][2], const Unit&, int, int, int, int) const {}
    __device__ __forceinline__ void operator()(const f32x4 (&acc)[2][2][4][2], const Unit& u, int wr, int wc, int fr, int fq) const {
#pragma unroll
        for (int ai = 0; ai < 2; ++ai)
#pragma unroll
            for (int m = 0; m < 4; ++m) {
                const int row = u.pm * BM + ai * HALF + wr * 64 + m * 16 + fr; float ss = 0.f;
#pragma unroll
                for (int bj = 0; bj < 2; ++bj)
#pragma unroll
                    for (int n = 0; n < 2; ++n) { const int c = u.pn * BM + bj * HALF + wc * 32 + 16 * n + 4 * fq; const size_t off = (size_t)row * DM_ + c;
                        const f32x4 x = *(const f32x4*)(base + off) + acc[ai][bj][m][n]; *(f32x4*)(out + off) = x;
                        ss += (x[0] * x[0] + x[1] * x[1]) + (x[2] * x[2] + x[3] * x[3]);
                        if (WRITE_XB) { const f32x4 g = *(const f32x4*)(gain + c); *(u32x2*)(XB + off) = pk4(x * g); } }
                ss += __shfl_xor(ss, 16); ss += __shfl_xor(ss, 32);
                if (fq == 0) SSQ[(size_t)row * 16 + u.pn * 4 + wc] = ss;
            }
    }
};
__device__ __forceinline__ float row_rstd(const float* SSQ, int row) {
    const f32x4 a = *(const f32x4*)(SSQ + (size_t)row * 16), b = *(const f32x4*)(SSQ + (size_t)row * 16 + 4), c = *(const f32x4*)(SSQ + (size_t)row * 16 + 8), d = *(const f32x4*)(SSQ + (size_t)row * 16 + 12);
    const float s = (((a[0] + a[1]) + (a[2] + a[3])) + ((b[0] + b[1]) + (b[2] + b[3]))) + (((c[0] + c[1]) + (c[2] + c[3])) + ((d[0] + d[1]) + (d[2] + d[3])));
    return 1.0f / sqrtf(s * (1.0f / 1024.0f) + 1e-6f);
}
struct EpiRowScale {
    static constexpr bool PERM = false, AFTER_DRAIN = false; static constexpr int MID_T = 0;
    const float* SSQ; bf16_t* OUT; float scale;
    __device__ __forceinline__ void mid(f32x4 (&)[2][2][4][2], const Unit&, int, int, int, int) const {}
    __device__ __forceinline__ void operator()(const f32x4 (&acc)[2][2][4][2], const Unit& u, int wr, int wc, int fr, int fq) const {
#pragma unroll
        for (int ai = 0; ai < 2; ++ai)
#pragma unroll
            for (int m = 0; m < 4; ++m) {
                const int row = u.pm * BM + ai * HALF + wr * 64 + m * 16 + fr; const float rs = row_rstd(SSQ, row) * scale;
#pragma unroll
                for (int bj = 0; bj < 2; ++bj)
#pragma unroll
                    for (int n = 0; n < 2; ++n) { const int c = u.pn * BM + bj * HALF + wc * 32 + 16 * n + 4 * fq; *(u32x2*)(OUT + (size_t)row * DM_ + c) = pk4(acc[ai][bj][m][n] * rs); }
            }
    }
};
struct EpiSwiGLU {
    static constexpr bool PERM = false, AFTER_DRAIN = false; static constexpr int MID_T = 0;
    const float* SSQ; bf16_t* OUT;
    __device__ __forceinline__ void mid(f32x4 (&)[2][2][4][2], const Unit&, int, int, int, int) const {}
    __device__ __forceinline__ void operator()(const f32x4 (&acc)[2][2][4][2], const Unit& u, int wr, int wc, int fr, int fq) const {
#pragma unroll
        for (int ai = 0; ai < 2; ++ai)
#pragma unroll
            for (int m = 0; m < 4; ++m) {
                const int row = u.pm * BM + ai * HALF + wr * 64 + m * 16 + fr; const float rs = row_rstd(SSQ, row);
#pragma unroll
                for (int bj = 0; bj < 2; ++bj) { const int cf = 128 * u.pn + 64 * bj + 16 * wc + 4 * fq; const f32x4 g = acc[ai][bj][m][0] * rs, up = acc[ai][bj][m][1] * rs; f32x4 a;
#pragma unroll
                    for (int i = 0; i < 4; ++i) a[i] = g[i] * sigmoidf_(g[i]) * up[i];
                    *(u32x2*)(OUT + (size_t)row * 2816 + cf) = pk4(a); }
            }
    }
};

template <class Epi, class Sched, bool ALIGN_EPI = false, bool SP2 = false>
__device__ __forceinline__ void gemm_phase(PG8_LAS unsigned char* lds, const Gemm g, const Sched& S, const Epi& E, int wave_s) {
    int tid_; asm volatile("v_mbcnt_lo_u32_b32 %0, -1, 0\n\tv_mbcnt_hi_u32_b32 %0, -1, %0" : "=v"(tid_)); tid_ += wave_s * 64;
    const int tid = tid_, wid = __builtin_amdgcn_readfirstlane(tid >> 6), lane = tid & 63, wr = wid >> 2, wc = wid & 3, fr = lane & 15, fq = lane >> 4;
    const int K = g.K, nt = K / BK;
    unsigned voffA[2], voffB[2];
#pragma unroll
    for (int i = 0; i < 2; ++i) { int R, C; stage_rc(tid * 16 + i * 8192, R, C); const int Rb = Epi::PERM ? ((R & ~31) + perm32(R & 31)) : R;
        voffA[i] = (unsigned)(R * K + C) * 2u; voffB[i] = (unsigned)(Rb * K + C) * 2u; }
    const size_t kstep = (size_t)(BK * 2);
    const size_t hstep = (size_t)HALF * K * 2;
    const size_t tstep = 2 * hstep;
    const unsigned ldsw = (unsigned)wid * 1024u;
    const int aoff = lds_byte(wr * 64 + fr, fq * 8), boff = lds_byte(wc * 32 + fr, fq * 8);
#define PG8_SA(b, h) (((b) * 2 + (h)) * HTB)
#define PG8_SB(b, h) ((4 + (b) * 2 + (h)) * HTB)
#define PG8_STAGE(bufoff, gbase, voff) do { _Pragma("unroll") for (int _i = 0; _i < 2; ++_i) \
        __builtin_amdgcn_global_load_lds((const unsigned*)((const char*)(gbase) + (voff)[_i]), (PG8_LAS unsigned*)(lds + (bufoff) + ldsw + _i * 8192), 16, 0, 0); } while (0)
#define PG8_LDA(dst, b, h) do { _Pragma("unroll") for (int m = 0; m < 4; ++m) _Pragma("unroll") for (int k = 0; k < 2; ++k) dst[m][k] = *(const PG8_LAS bf16x8*)(lds + PG8_SA(b, h) + aoff + m * 2048 + k * 1024); } while (0)
#define PG8_LDB(dst, b, h) do { _Pragma("unroll") for (int n = 0; n < 2; ++n) _Pragma("unroll") for (int k = 0; k < 2; ++k) dst[n][k] = *(const PG8_LAS bf16x8*)(lds + PG8_SB(b, h) + boff + n * 2048 + k * 1024); } while (0)
#define PG8_MMA(ai, bj, At, Bt) do { __builtin_amdgcn_s_setprio(1); _Pragma("unroll") for (int m = 0; m < 4; ++m) _Pragma("unroll") for (int n = 0; n < 2; ++n) _Pragma("unroll") for (int k = 0; k < 2; ++k) \
        acc[ai][bj][m][n] = __builtin_amdgcn_mfma_f32_16x16x32_bf16(Bt[n][k], At[m][k], acc[ai][bj][m][n], 0, 0, 0); __builtin_amdgcn_s_setprio(0); } while (0)
#define PG8_WAIT_V(n) asm volatile("s_waitcnt vmcnt(" #n ")" ::: "memory")
#define PG8_WAIT_L(n) asm volatile("s_waitcnt lgkmcnt(" #n ")" ::: "memory")
#define PG8_BAR __builtin_amdgcn_s_barrier()
#define PG8_SCHED __builtin_amdgcn_sched_barrier(0)
    Unit cur, nxt; int ui = 0;
    if (!S.next(0, cur)) return;
    f32x4 acc[2][2][4][2];
#pragma unroll
    for (int a = 0; a < 2; ++a)
#pragma unroll
        for (int b = 0; b < 2; ++b)
#pragma unroll
            for (int m = 0; m < 4; ++m)
#pragma unroll
                for (int n = 0; n < 2; ++n) acc[a][b][m][n] = (f32x4){0.f, 0.f, 0.f, 0.f};
    bf16x8 At[4][2], B0[2][2], B1[2][2];
    const char* cA = (const char*)g.A + (size_t)cur.pm * tstep; const char* cB = (const char*)g.Bt + (size_t)cur.pn * tstep;
    S.a_ready(cur);
    if constexpr (SP2) {
        PG8_STAGE(PG8_SB(0, 0), cB, voffB); PG8_STAGE(PG8_SB(0, 1), cB + hstep, voffB); PG8_STAGE(PG8_SA(0, 0), cA, voffA); PG8_STAGE(PG8_SA(0, 1), cA + hstep, voffA);
        if (wr == 1) PG8_BAR;
        PG8_WAIT_V(2); PG8_BAR;
        PG8_STAGE(PG8_SB(1, 0), cB + kstep, voffB); PG8_STAGE(PG8_SA(1, 0), cA + kstep, voffA); PG8_STAGE(PG8_SB(1, 1), cB + hstep + kstep, voffB);
        PG8_WAIT_V(6); PG8_BAR;
    } else {
        PG8_STAGE(PG8_SB(0, 0), cB, voffB); PG8_STAGE(PG8_SA(0, 0), cA, voffA); PG8_STAGE(PG8_SB(0, 1), cB + hstep, voffB); PG8_STAGE(PG8_SA(0, 1), cA + hstep, voffA);
        if (wr == 1) PG8_BAR;
        PG8_WAIT_V(4); PG8_BAR;
        PG8_STAGE(PG8_SB(1, 0), cB + kstep, voffB); PG8_STAGE(PG8_SA(1, 0), cA + kstep, voffA); PG8_STAGE(PG8_SB(1, 1), cB + hstep + kstep, voffB);
        PG8_WAIT_V(6); PG8_BAR;
    }
    for (;;) {
        const bool has_next = S.next(ui + 1, nxt);
        const char* nA = has_next ? (const char*)g.A + (size_t)nxt.pm * tstep : cA; const char* nB = has_next ? (const char*)g.Bt + (size_t)nxt.pn * tstep : cB;
        for (int t = 0; t < nt; t += 2) {
            const bool last = (t == nt - 2);
            if constexpr (Epi::MID_T > 0) { if (t == Epi::MID_T) E.mid(acc, cur, wr, wc, fr, fq); }
            const char* a1 = cA + (size_t)(t + 1) * kstep;
            const char* a2 = last ? nA : cA + (size_t)(t + 2) * kstep; const char* b2 = last ? nB : cB + (size_t)(t + 2) * kstep;
            const char* a3 = a2 + kstep; const char* b3 = b2 + kstep;
            if (last && has_next) S.a_ready(nxt);
            if constexpr (SP2) {
            PG8_LDB(B0, 0, 0); PG8_LDB(B1, 0, 1); PG8_SCHED; PG8_LDA(At, 0, 0); PG8_STAGE(PG8_SA(1, 1), a1 + hstep, voffA);
            PG8_WAIT_V(8); PG8_WAIT_L(0); PG8_BAR; PG8_MMA(0, 0, At, B0); PG8_MMA(0, 1, At, B1); PG8_BAR; PG8_SCHED;
            PG8_LDA(At, 0, 1); PG8_STAGE(PG8_SB(0, 0), b2, voffB); PG8_STAGE(PG8_SB(0, 1), b2 + hstep, voffB); PG8_STAGE(PG8_SA(0, 0), a2, voffA);
            PG8_WAIT_V(8); PG8_WAIT_L(0); PG8_BAR; PG8_MMA(1, 0, At, B0); PG8_MMA(1, 1, At, B1); PG8_BAR; PG8_SCHED;
            PG8_LDB(B0, 1, 0); PG8_LDB(B1, 1, 1); PG8_SCHED; PG8_LDA(At, 1, 0); PG8_STAGE(PG8_SA(0, 1), a2 + hstep, voffA);
            PG8_WAIT_V(8); PG8_WAIT_L(0); PG8_BAR; PG8_MMA(0, 0, At, B0); PG8_MMA(0, 1, At, B1); PG8_BAR; PG8_SCHED;
            PG8_LDA(At, 1, 1); PG8_STAGE(PG8_SB(1, 0), b3, voffB); PG8_STAGE(PG8_SB(1, 1), b3 + hstep, voffB); PG8_STAGE(PG8_SA(1, 0), a3, voffA);
            PG8_WAIT_V(8); PG8_WAIT_L(0); PG8_BAR; PG8_MMA(1, 0, At, B0); PG8_MMA(1, 1, At, B1); PG8_BAR; PG8_SCHED;
            } else {
            PG8_LDB(B0, 0, 0); PG8_SCHED; PG8_LDA(At, 0, 0); PG8_STAGE(PG8_SA(1, 1), a1 + hstep, voffA);
            PG8_WAIT_L(8); PG8_BAR; PG8_WAIT_L(0); PG8_MMA(0, 0, At, B0); PG8_BAR; PG8_SCHED;
            PG8_LDB(B1, 0, 1); PG8_STAGE(PG8_SB(0, 0), b2, voffB);
            PG8_BAR; PG8_WAIT_L(0); PG8_MMA(0, 1, At, B1); PG8_BAR;
            PG8_LDA(At, 0, 1); PG8_STAGE(PG8_SA(0, 0), a2, voffA);
            PG8_BAR; PG8_WAIT_L(0); PG8_MMA(1, 0, At, B0); PG8_BAR; PG8_SCHED;
            PG8_STAGE(PG8_SB(0, 1), b2 + hstep, voffB);
            PG8_WAIT_V(6); PG8_BAR; PG8_MMA(1, 1, At, B1); PG8_BAR;
            PG8_LDB(B0, 1, 0); PG8_SCHED; PG8_LDA(At, 1, 0); PG8_STAGE(PG8_SA(0, 1), a2 + hstep, voffA);
            PG8_WAIT_L(8); PG8_BAR; PG8_WAIT_L(0); PG8_MMA(0, 0, At, B0); PG8_BAR; PG8_SCHED;
            PG8_LDB(B1, 1, 1); PG8_STAGE(PG8_SB(1, 0), b3, voffB);
            PG8_BAR; PG8_WAIT_L(0); PG8_MMA(0, 1, At, B1); PG8_BAR;
            PG8_LDA(At, 1, 1); PG8_STAGE(PG8_SA(1, 0), a3, voffA);
            PG8_BAR; PG8_WAIT_L(0); PG8_MMA(1, 0, At, B0); PG8_BAR; PG8_SCHED;
            PG8_STAGE(PG8_SB(1, 1), b3 + hstep, voffB);
            PG8_WAIT_V(6); PG8_BAR; PG8_MMA(1, 1, At, B1); PG8_BAR;
            }
        }
        if constexpr (ALIGN_EPI) { if (wr == 0) PG8_BAR; }
        if constexpr (!Epi::AFTER_DRAIN) { E(acc, cur, wr, wc, fr, fq); S.done(cur); }
        if (!has_next) break;
#pragma unroll
        for (int a = 0; a < 2; ++a)
#pragma unroll
            for (int b = 0; b < 2; ++b)
#pragma unroll
                for (int m = 0; m < 4; ++m)
#pragma unroll
                    for (int n = 0; n < 2; ++n) acc[a][b][m][n] = (f32x4){0.f, 0.f, 0.f, 0.f};
        cur = nxt; cA = nA; cB = nB; ++ui;
        if constexpr (ALIGN_EPI) { if (wr == 1) PG8_BAR; }
    }
    PG8_WAIT_V(0);
    if constexpr (!ALIGN_EPI) { if (wr == 0) PG8_BAR; }
    PG8_BAR;
    if constexpr (Epi::AFTER_DRAIN) { E.fused(acc, cur, wr, wc, fr, fq, lds, wid, lane); S.done(cur); }
#undef PG8_SA
#undef PG8_SB
#undef PG8_STAGE
#undef PG8_LDA
#undef PG8_LDB
#undef PG8_MMA
#undef PG8_WAIT_V
#undef PG8_WAIT_L
#undef PG8_BAR
#undef PG8_SCHED
}
}


constexpr int NWAVES = 8;
constexpr int BATCH = 8, SEQ = 4096, DM = 1024, MTOK = BATCH * SEQ, MEML = 256, MMEM = BATCH * MEML;
constexpr int INC = 6656, DFF = 2816, NCHUNK = 32;
constexpr float EPS = 1e-6f, LOG2E = 1.4426950408889634f;
#define NEG_INF (-__builtin_inff())

constexpr size_t MiB = 1u << 20;
constexpr size_t WS_CTL = 0, WS_KMEAN = 256 * 1024, CTL_ZERO_BYTES = 512 * 1024;
constexpr size_t WS_T64 = 1 * MiB, WS_T128 = 2 * MiB, WS_MEMN = 4 * MiB, WS_KX = 8 * MiB, WS_VXT = 12 * MiB;
constexpr size_t WS_WIN = 16 * MiB, WS_WAB = 29 * MiB, WS_WOUT = 32 * MiB, WS_WXQ = 34 * MiB, WS_WXKV = 36 * MiB, WS_WXO = 40 * MiB, WS_WGU = 42 * MiB, WS_WDN = 53 * MiB;
constexpr size_t WS_H = 60 * MiB, WS_YAB = 124 * MiB, WS_AK = 220 * MiB, WS_AVT = 252 * MiB, WS_RQ = 284 * MiB, WS_RK = 316 * MiB, WS_RKT = 348 * MiB, WS_RVT = 380 * MiB, WS_RG = 444 * MiB, WS_END = 508 * MiB;
constexpr size_t WS_ST = WS_H, WS_QX = WS_H, WS_MERGED = WS_AK, WS_OX = WS_AK, WS_X1 = 284 * MiB, WS_SSQ1 = 412 * MiB, WS_SSQ2 = 414 * MiB, WS_SSQ3 = 416 * MiB, WS_XB = WS_RG, WS_ACT = 60 * MiB;
static_assert(WS_WDN + (size_t)DM * DFF * 2 <= WS_H && WS_ACT + (size_t)MTOK * DFF * 2 <= WS_X1 && WS_X1 + (size_t)MTOK * DM * 4 <= WS_SSQ1 && WS_SSQ3 + 2 * MiB <= WS_XB, "d_ws map");
constexpr int CW_TMO = 0, CW_CODE = 1, CW_BAR = 4096, CW_Q = 8192;

constexpr int RING_OFF = 0, RING_BYTES = 131072;
constexpr int LDSCTL_OFF = RING_BYTES, MISC_OFF = LDSCTL_OFF + 320;
constexpr int LDS_BYTES = 147456;

#define GAS __attribute__((address_space(1)))
#define LAS __attribute__((address_space(3)))
typedef unsigned short bf16;
typedef unsigned v4u __attribute__((ext_vector_type(4)));
typedef float f32x4 __attribute__((ext_vector_type(4)));
typedef short bf16x8 __attribute__((ext_vector_type(8)));
typedef GAS unsigned gu32;
typedef GAS unsigned long long gu64;
#define RLX_AGENT __ATOMIC_RELAXED, __HIP_MEMORY_SCOPE_AGENT
#define LDS_WAIT() asm volatile("s_waitcnt lgkmcnt(0)" ::: "memory")
#define VM_WAIT() asm volatile("s_waitcnt vmcnt(0)" ::: "memory")
__device__ __forceinline__ unsigned long long rt() { return __builtin_amdgcn_s_memrealtime(); }
__device__ __forceinline__ unsigned f2bf(float f) { unsigned u = __builtin_bit_cast(unsigned, f); return (u + 0x7fffu + ((u >> 16) & 1u)) >> 16; }
__device__ __forceinline__ unsigned pk2(float lo, float hi) { return f2bf(lo) | (f2bf(hi) << 16); }

#define XB_TMO      128
#define XB_XCNT(j)  (256  + 64 * (j))
#define XB_XSUB(j)  (1280 + 64 * (j))
#define XB_XGEN(j)  (2304 + 64 * (j))
#define XB_TOP      3328
#define XB_TOPGEN   3392
#define XCD_BAR_WORDS 3456
#define XB_SPIN_CAP (1u << 18)

__device__ __forceinline__ unsigned xb_ld(unsigned* p)              { return __hip_atomic_load(p, __ATOMIC_RELAXED, __HIP_MEMORY_SCOPE_AGENT); }
__device__ __forceinline__ unsigned xb_add(unsigned* p, unsigned v) { return __hip_atomic_fetch_add(p, v, __ATOMIC_RELAXED, __HIP_MEMORY_SCOPE_AGENT); }
__device__ __forceinline__ unsigned xb_xcc_id() { return (unsigned)__builtin_amdgcn_s_getreg((3 << 11) | 20) & 0xFu; }
#define XB_SPIN(cond, bar) do { unsigned _sp = 0; while (cond) { __builtin_amdgcn_s_sleep(1); \
    if ((++_sp & 255u) == 0u) { if (xb_ld(&(bar)[XB_TMO])) break; if (_sp > XB_SPIN_CAP) { atomicAdd(&(bar)[XB_TMO], 1u); break; } } } } while (0)

struct XcdBarrier {
    unsigned* bar; unsigned x;
    volatile LAS unsigned* st;
};

__device__ __forceinline__ XcdBarrier xcd_barrier_post(unsigned* bar, volatile LAS unsigned* st) {
    XcdBarrier b; b.bar = bar; b.x = xb_xcc_id(); b.st = st;
    if (threadIdx.x == 0) (void)xb_add(&bar[XB_XCNT(b.x)], 1u);
    return b;
}
__device__ __forceinline__ void xcd_barrier_complete(unsigned* bar, unsigned x, unsigned& nloc, unsigned& nx) {
    const unsigned G = gridDim.x * gridDim.y * gridDim.z;
    unsigned sum, cnt, mine, sp = 0u;
    for (;;) {
        sum = 0u; cnt = 0u; mine = 0u;
#pragma unroll
        for (unsigned j = 0; j < 16; ++j) { const unsigned c = xb_ld(&bar[XB_XCNT(j)]); sum += c; cnt += (c > 0u) ? 1u : 0u; mine = (j == x) ? c : mine; }
        if (sum == G) break;
        __builtin_amdgcn_s_sleep(1);
        if ((++sp & 255u) == 0u) { if (xb_ld(&bar[XB_TMO])) break; if (sp > XB_SPIN_CAP) { atomicAdd(&bar[XB_TMO], 1u); break; } }
    }
    nloc = mine > 0u ? mine : 1u; nx = cnt > 0u ? cnt : 1u;
}

__device__ __forceinline__ void xcd_barrier(const XcdBarrier& b) {
    asm volatile("s_waitcnt vmcnt(0)" ::: "memory");
    __syncthreads();
    if (threadIdx.x == 0) {
        unsigned* bar = b.bar;
        __builtin_amdgcn_s_waitcnt(0);
        unsigned nloc = b.st[0], nx = b.st[1];
        if (nloc == 0u) { xcd_barrier_complete(bar, b.x, nloc, nx); b.st[0] = nloc; b.st[1] = nx; }
        const unsigned old = xb_add(&bar[XB_XSUB(b.x)], 1u);
        const unsigned gen = old / nloc;
        if (old + 1u == (gen + 1u) * nloc) {
            __builtin_amdgcn_fence(__ATOMIC_RELEASE, "agent");
            asm volatile("s_waitcnt vmcnt(0)" ::: "memory");
            const unsigned og = xb_add(&bar[XB_TOP], 1u);
            const unsigned tg = og / nx;
            if (og + 1u == (tg + 1u) * nx) xb_add(&bar[XB_TOPGEN], 1u);
            else XB_SPIN(xb_ld(&bar[XB_TOPGEN]) == tg, bar);
            __builtin_amdgcn_fence(__ATOMIC_ACQUIRE, "agent");
            xb_add(&bar[XB_XGEN(b.x)], 1u);
            asm volatile("s_waitcnt vmcnt(0)" ::: "memory");
        } else {
            XB_SPIN(xb_ld(&bar[XB_XGEN(b.x)]) == gen, bar);
            __builtin_amdgcn_fence(__ATOMIC_ACQUIRE, "agent");
            asm volatile("s_waitcnt vmcnt(0)" ::: "memory");
        }
    }
    __syncthreads();
}

__device__ __forceinline__ int lane_id_v() { int l; asm volatile("v_mbcnt_lo_u32_b32 %0, -1, 0\n\tv_mbcnt_hi_u32_b32 %0, -1, %0" : "=v"(l)); return l; }
__device__ __forceinline__ float wave_sum(float v) {
#pragma unroll
    for (int o = 1; o < 64; o <<= 1) v += __shfl_xor(v, o);
    return v;
}
__device__ __forceinline__ void col_map(int kind, int p, int& which, int& col, float& sc) {
    which = 0; col = p; sc = 1.0f;
    if (kind == 1) {
        const int pn = p >> 8, cp = p & 255;
        if (pn < 4) { const int rc = (pn & 1) * 256 + cp, hh = rc >> 6, oo = rc & 63, f = 16 * (oo >> 5) + (oo & 15), half = (oo >> 4) & 1; col = (pn >> 1) * 512 + hh * 64 + half * 32 + f; if (pn < 2) sc = 0.125f * LOG2E; }
        else if (pn < 6) { col = 1024 + (pn - 4) * 256 + cp; }
        else if (pn < 10) { const int rc = (pn & 1) * 256 + cp, hh = rc >> 7, oo = rc & 127, f = 16 * (oo >> 5) + (oo & 15), half = (oo >> 4) & 1; col = 1536 + ((pn - 6) >> 1) * 512 + hh * 128 + half * 64 + f; if (pn >= 8) sc = 0.08838834764831845f; }
        else if (pn < 18) { col = 2560 + (pn - 10) * 256 + cp; }
        else { const int q = pn - 18, bj = cp >> 7, wc = (cp >> 5) & 3, n = (cp >> 4) & 1; col = (n ? 5632 : 4608) + 128 * q + 64 * bj + 16 * wc + (cp & 15); }
    } else if (kind == 2) {
        const int q = p >> 8, cp = p & 255, bj = cp >> 7, wc = (cp >> 5) & 3, n = (cp >> 4) & 1; which = n; col = 128 * q + 64 * bj + 16 * wc + (cp & 15);
    }
}
__device__ __forceinline__ void p0_transpose_item(const float* s0, const float* s1, int N, int Np, int kind, bf16* WT, int ldt, int koff, LAS float* scr, int item, int lane) {
    const int nblk = Np / 32, kb = item / nblk, nb = item % nblk, k0 = 64 * kb, n0 = 32 * nb;
    int which, col; float sc; col_map(kind, n0 + (lane & 31), which, col, sc);
    const float* src = (which ? s1 : s0) + col;
#pragma unroll 8
    for (int i = 0; i < 32; ++i) { const int kk = 2 * i + (lane >> 5); scr[kk * 33 + (lane & 31)] = src[(size_t)(k0 + kk) * N] * sc; }
    LDS_WAIT(); asm volatile("" ::: "memory");
    const int c = lane & 7;
#pragma unroll
    for (int j = 0; j < 4; ++j) { const int n = (lane >> 3) + 8 * j; const LAS float* s = scr + (8 * c) * 33 + n;
        v4u o; o.x = pk2(s[0 * 33], s[1 * 33]); o.y = pk2(s[2 * 33], s[3 * 33]); o.z = pk2(s[4 * 33], s[5 * 33]); o.w = pk2(s[6 * 33], s[7 * 33]);
        *(GAS v4u*)(WT + (size_t)(n0 + n) * ldt + koff + k0 + 8 * c) = o; }
    LDS_WAIT(); asm volatile("" ::: "memory");
}
__device__ __forceinline__ void rms_row_to_bf16(const float* xrow, const float* gain, bf16* orow, int lane) {
    const GAS f32x4* xr = (const GAS f32x4*)xrow + lane; const GAS f32x4* gr = (const GAS f32x4*)gain + lane;
    f32x4 v[4]; float s = 0.f;
#pragma unroll
    for (int j = 0; j < 4; ++j) { v[j] = xr[64 * j]; s += (v[j].x * v[j].x + v[j].y * v[j].y) + (v[j].z * v[j].z + v[j].w * v[j].w); }
    const float rstd = 1.f / sqrtf(wave_sum(s) * (1.f / DM) + EPS);
    GAS unsigned long long* o8 = (GAS unsigned long long*)orow + lane;
#pragma unroll
    for (int j = 0; j < 4; ++j) { const f32x4 g = gr[64 * j]; o8[64 * j] = (unsigned long long)pk2(v[j].x * rstd * g.x, v[j].y * rstd * g.y) | ((unsigned long long)pk2(v[j].z * rstd * g.z, v[j].w * rstd * g.w) << 32); }
}
__device__ __forceinline__ void rope_cs(int pos, int f, int dh, float& c, float& s) {
    const float inv = exp2f(-((float)(2 * f) / (float)dh) * 13.287712379549449f);
    const float ang = (float)pos * inv;
    const double x = (double)ang, n = __builtin_rint(x * 0.15915494309189535);
    double r = __builtin_fma(-n, 6.283185307179586, x); r = __builtin_fma(-n, 2.4492935982947064e-16, r);
    const double r2 = r * r; double ts = r, ss = r, tc = 1.0, sc = 1.0;
#pragma unroll 1
    for (int k = 1; k <= 15; ++k) { tc *= -r2 / (double)((2 * k - 1) * (2 * k)); sc += tc; ts *= -r2 / (double)((2 * k) * (2 * k + 1)); ss += ts; }
    c = (float)sc; s = (float)ss;
}

typedef float f32x16 __attribute__((ext_vector_type(16)));
typedef short s16x4 __attribute__((ext_vector_type(4)));
#define MFMA32(a, b, c) __builtin_amdgcn_mfma_f32_32x32x16_bf16((a), (b), (c), 0, 0, 0)
__device__ __forceinline__ int crow(int r, int hi) { return (r & 3) + 8 * (r >> 2) + 4 * hi; }
__device__ __forceinline__ bf16x8 ld16(const bf16* p) { return *(const bf16x8*)p; }
__device__ __forceinline__ bf16x8 ld8x2(const bf16* p) { const s16x4 a = *(const s16x4*)p, b = *(const s16x4*)(p + 8); return (bf16x8){a[0], a[1], a[2], a[3], b[0], b[1], b[2], b[3]}; }
__device__ __forceinline__ float bf2f(short b) { return __builtin_bit_cast(float, (unsigned)(unsigned short)b << 16); }
template <int BASE> __device__ __forceinline__ bf16x8 pack8(const f32x16& p) {
    v4u w; w.x = pk2(p[BASE], p[BASE + 1]); w.y = pk2(p[BASE + 2], p[BASE + 3]); w.z = pk2(p[BASE + 4], p[BASE + 5]); w.w = pk2(p[BASE + 6], p[BASE + 7]);
    return __builtin_bit_cast(bf16x8, w);
}
__device__ __forceinline__ f32x16 splat16(float v) { f32x16 r;
#pragma unroll
    for (int i = 0; i < 16; ++i) r[i] = v;
    return r; }
template <int NS, int NO>
__device__ __forceinline__ void attn_tile(const bf16* Kp, size_t KP, const bf16* VTp, size_t VP, const bf16x8 (&qf)[NS], float& m_run, float& l_run, f32x16 (&o)[NO], int maskmode, int qd, bool lane_on, int hh) {
    f32x16 p0 = splat16(0.f), p1 = splat16(0.f);
#pragma unroll
    for (int s = 0; s < NS; ++s) { const bf16x8 a0 = ld16(Kp + 16 * s), a1 = ld16(Kp + 32 * KP + 16 * s); p0 = MFMA32(a0, qf[s], p0); p1 = MFMA32(a1, qf[s], p1); }
    if (maskmode == 1) {
#pragma unroll
        for (int rg = 0; rg < 16; ++rg) { const int kv = crow(rg, hh); if (kv > qd) p0[rg] = NEG_INF; if (kv + 32 > qd) p1[rg] = NEG_INF; }
    } else if (maskmode == 2) {
        if (!lane_on) { p0 = splat16(NEG_INF); p1 = splat16(NEG_INF); }
    }
    float tm = p0[0];
#pragma unroll
    for (int rg = 1; rg < 16; ++rg) tm = fmaxf(tm, p0[rg]);
#pragma unroll
    for (int rg = 0; rg < 16; ++rg) tm = fmaxf(tm, p1[rg]);
    tm = fmaxf(tm, __shfl_xor(tm, 32));
    const float mnew = fmaxf(m_run, tm), msafe = (mnew == NEG_INF) ? 0.f : mnew;
    const float alpha = __builtin_amdgcn_exp2f(m_run - msafe);
    float sum = 0.f;
#pragma unroll
    for (int rg = 0; rg < 16; ++rg) { p0[rg] = __builtin_amdgcn_exp2f(p0[rg] - msafe); p1[rg] = __builtin_amdgcn_exp2f(p1[rg] - msafe); sum += p0[rg] + p1[rg]; }
    l_run = l_run * alpha + sum; m_run = mnew;
    const bf16x8 pb0 = pack8<0>(p0), pb1 = pack8<8>(p0), pb2 = pack8<0>(p1), pb3 = pack8<8>(p1);
#pragma unroll
    for (int db = 0; db < NO; ++db) { const bf16* vr = VTp + (size_t)(32 * db) * VP; o[db] = o[db] * alpha;
        o[db] = MFMA32(ld8x2(vr), pb0, o[db]); o[db] = MFMA32(ld8x2(vr + 16), pb1, o[db]); o[db] = MFMA32(ld8x2(vr + 32), pb2, o[db]); o[db] = MFMA32(ld8x2(vr + 48), pb3, o[db]); }
}

__device__ __forceinline__ void moba_item(bf16* YAB, const bf16* AK, const bf16* AVT, const float* KMEAN, int b, int h, int qb, int w, int lane) {
    const int r = lane & 31, hh = lane >> 5, qrel = 32 * w + r;
    bf16* Qp = YAB + ((size_t)b * SEQ + qb * 256 + qrel) * 1536 + h * 64;
    bf16x8 qf[4];
#pragma unroll
    for (int s = 0; s < 4; ++s) qf[s] = ld16(Qp + 16 * s + 8 * hh);
    unsigned selmask = 0u;
    if (qb > 0) {
        const float* km = KMEAN + (size_t)(b * 16) * 512 + h * 64 + 8 * hh;
        float v1 = NEG_INF, v2 = NEG_INF, v3 = NEG_INF; int i1 = -1, i2 = -1, i3 = -1;
        for (int j = 0; j < qb; ++j) {
            float dot = 0.f;
#pragma unroll
            for (int s = 0; s < 4; ++s) { const f32x4 ka = *(const f32x4*)(km + (size_t)j * 512 + 16 * s), kb = *(const f32x4*)(km + (size_t)j * 512 + 16 * s + 4);
                dot += bf2f(qf[s][0]) * ka[0] + bf2f(qf[s][1]) * ka[1] + bf2f(qf[s][2]) * ka[2] + bf2f(qf[s][3]) * ka[3] + bf2f(qf[s][4]) * kb[0] + bf2f(qf[s][5]) * kb[1] + bf2f(qf[s][6]) * kb[2] + bf2f(qf[s][7]) * kb[3]; }
            dot += __shfl_xor(dot, 32);
            if (dot > v1) { v3 = v2; i3 = i2; v2 = v1; i2 = i1; v1 = dot; i1 = j; } else if (dot > v2) { v3 = v2; i3 = i2; v2 = dot; i2 = j; } else if (dot > v3) { v3 = dot; i3 = j; }
        }
        if (i1 >= 0) selmask |= 1u << i1; if (i2 >= 0) selmask |= 1u << i2; if (i3 >= 0) selmask |= 1u << i3;
    }
    float m_run = NEG_INF, l_run = 0.f; f32x16 o[2]; o[0] = splat16(0.f); o[1] = splat16(0.f);
    const bf16* Kh = AK + (size_t)b * SEQ * 512 + h * 64 + 8 * hh;
    const bf16* Vh = AVT + ((size_t)((b * 8 + h) * 64 + r)) * SEQ + 4 * hh;
    for (int c = 0; c <= (w >> 1); ++c) {
        const int kpos = qb * 256 + 64 * c;
        attn_tile<4, 2>(Kh + (size_t)(kpos + r) * 512, 512, Vh + kpos, SEQ, qf, m_run, l_run, o, 1, qrel - 64 * c, true, hh);
    }
    for (int j = 0; j < qb; ++j) {
        const bool on = (selmask >> j) & 1u;
        if (!__any(on)) continue;
        for (int c = 0; c < 4; ++c) { const int kpos = j * 256 + 64 * c;
            attn_tile<4, 2>(Kh + (size_t)(kpos + r) * 512, 512, Vh + kpos, SEQ, qf, m_run, l_run, o, 2, 0, on, hh); }
    }
    const float inv = 1.0f / (l_run + __shfl_xor(l_run, 32));
#pragma unroll
    for (int db = 0; db < 2; ++db)
#pragma unroll
        for (int g = 0; g < 4; ++g) {
            const unsigned lo = pk2(o[db][4 * g] * inv, o[db][4 * g + 1] * inv), hi = pk2(o[db][4 * g + 2] * inv, o[db][4 * g + 3] * inv);
            *(unsigned long long*)(Qp + 32 * db + 8 * g + 4 * hh) = (unsigned long long)lo | ((unsigned long long)hi << 32); }
}

__device__ __forceinline__ void scan_item(const bf16* RKT, const bf16* RVT, bf16* ST, int b, int hr, int es, int lane) {
    const int r = lane & 31, hh = lane >> 5; const float dec = __builtin_amdgcn_exp2f(128.0f * pg8::lg2gamma(hr));
    f32x16 st[4];
#pragma unroll
    for (int db = 0; db < 4; ++db) st[db] = splat16(0.f);
    const bf16* kt = RKT + ((size_t)((b * 4 + hr) * 128 + r)) * SEQ + 8 * hh;
    const bf16* vt = RVT + ((size_t)((b * 4 + hr) * 256 + 32 * es + r)) * SEQ + 8 * hh;
    bf16* sto = ST + (((size_t)((b * 4 + hr) * NCHUNK)) * 256 + 32 * es + r) * 128 + 4 * hh;
    for (int n = 0; n < NCHUNK; ++n) {
#pragma unroll
        for (int db = 0; db < 4; ++db)
#pragma unroll
            for (int g = 0; g < 4; ++g) { const unsigned lo = pk2(st[db][4 * g], st[db][4 * g + 1]), hi = pk2(st[db][4 * g + 2], st[db][4 * g + 3]);
                *(unsigned long long*)(sto + (size_t)n * 256 * 128 + 32 * db + 8 * g) = (unsigned long long)lo | ((unsigned long long)hi << 32); }
        if (n == NCHUNK - 1) break;
        bf16x8 vf[8];
#pragma unroll
        for (int s = 0; s < 8; ++s) vf[s] = ld16(vt + n * 128 + 16 * s);
#pragma unroll
        for (int db = 0; db < 4; ++db) { st[db] = st[db] * dec;
#pragma unroll
            for (int s = 0; s < 8; ++s) st[db] = MFMA32(ld16(kt + (size_t)(32 * db) * SEQ + n * 128 + 16 * s), vf[s], st[db]); }
    }
}

__device__ __forceinline__ void retc_item(const bf16* RQ, const bf16* RK, const bf16* RVT, const bf16* ST, const bf16* RG, bf16* YAB, int b, int hr, int n, int ib, int lane) {
    const int r = lane & 31, hh = lane >> 5, il = 32 * ib + r; const float lg = pg8::lg2gamma(hr);
    const size_t trow = (size_t)b * SEQ + n * 128 + il;
    bf16x8 qf[8];
#pragma unroll
    for (int s = 0; s < 8; ++s) qf[s] = ld16(RQ + trow * 512 + hr * 128 + 16 * s + 8 * hh);
    f32x16 acc[8];
#pragma unroll
    for (int eb = 0; eb < 8; ++eb) acc[eb] = splat16(0.f);
    const bf16* stp = ST + (((size_t)((b * 4 + hr) * NCHUNK + n)) * 256 + r) * 128 + 8 * hh;
#pragma unroll
    for (int eb = 0; eb < 8; ++eb)
#pragma unroll
        for (int s = 0; s < 8; ++s) acc[eb] = MFMA32(ld16(stp + (size_t)(32 * eb) * 128 + 16 * s), qf[s], acc[eb]);
    const float qd = __builtin_amdgcn_exp2f((float)(il + 1) * lg);
#pragma unroll
    for (int eb = 0; eb < 8; ++eb) acc[eb] = acc[eb] * qd;
    const bf16* vt = RVT + ((size_t)((b * 4 + hr) * 256 + r)) * SEQ + n * 128 + 4 * hh;
    for (int jb = 0; jb <= ib; ++jb) {
        f32x16 sT = splat16(0.f);
        const bf16* kp = RK + ((size_t)b * SEQ + n * 128 + 32 * jb + r) * 512 + hr * 128 + 8 * hh;
#pragma unroll
        for (int s = 0; s < 8; ++s) sT = MFMA32(ld16(kp + 16 * s), qf[s], sT);
#pragma unroll
        for (int rg = 0; rg < 16; ++rg) { const int diff = il - (32 * jb + crow(rg, hh)); sT[rg] = diff >= 0 ? sT[rg] * __builtin_amdgcn_exp2f((float)diff * lg) : 0.f; }
        const bf16x8 pb0 = pack8<0>(sT), pb1 = pack8<8>(sT);
#pragma unroll
        for (int eb = 0; eb < 8; ++eb) { const bf16* vr = vt + (size_t)(32 * eb) * SEQ + 32 * jb; acc[eb] = MFMA32(ld8x2(vr), pb0, acc[eb]); acc[eb] = MFMA32(ld8x2(vr + 16), pb1, acc[eb]); }
    }
    float s1 = 0.f, s2 = 0.f;
#pragma unroll
    for (int eb = 0; eb < 8; ++eb)
#pragma unroll
        for (int rg = 0; rg < 16; ++rg) { s1 += acc[eb][rg]; s2 += acc[eb][rg] * acc[eb][rg]; }
    s1 += __shfl_xor(s1, 32); s2 += __shfl_xor(s2, 32);
    const float mean = s1 * (1.0f / 256.0f), var = fmaxf(s2 * (1.0f / 256.0f) - mean * mean, 0.f), rstd = 1.0f / sqrtf(var + EPS);
    const bf16* rgp = RG + trow * 1024 + hr * 256 + 4 * hh; bf16* yo = YAB + trow * 1536 + 512 + hr * 256 + 4 * hh;
#pragma unroll
    for (int eb = 0; eb < 8; ++eb)
#pragma unroll
        for (int g = 0; g < 4; ++g) { const pg8::u32x2 gw = *(const pg8::u32x2*)(rgp + 32 * eb + 8 * g); const f32x4 gt = pg8::unpk4(gw); f32x4 y;
#pragma unroll
            for (int i = 0; i < 4; ++i) y[i] = (acc[eb][4 * g + i] - mean) * rstd * gt[i];
            *(pg8::u32x2*)(yo + 32 * eb + 8 * g) = pg8::pk4(y); }
}

__device__ __forceinline__ void xattn_item(const bf16* QX, const bf16* KX, const bf16* VXT, bf16* OX, int b, int hx, int qt, int dh, int lane) {
    const int r = lane & 31, hh = lane >> 5; const size_t qrow = (size_t)b * SEQ + 32 * qt + r;
    bf16x8 qf[16];
#pragma unroll
    for (int s = 0; s < 16; ++s) qf[s] = ld16(QX + qrow * 1024 + hx * 256 + 16 * s + 8 * hh);
    float m_run = NEG_INF, l_run = 0.f; f32x16 o[4];
#pragma unroll
    for (int db = 0; db < 4; ++db) o[db] = splat16(0.f);
    for (int kt = 0; kt < 4; ++kt) {
        const bf16* Kp = KX + ((size_t)(b * 256 + 64 * kt + r)) * 1024 + hx * 256 + 8 * hh;
        const bf16* VTp = VXT + ((size_t)((b * 4 + hx) * 256 + 128 * dh + r)) * 256 + 64 * kt + 4 * hh;
        attn_tile<16, 4>(Kp, 1024, VTp, 256, qf, m_run, l_run, o, 0, 0, true, hh);
    }
    const float inv = 1.0f / (l_run + __shfl_xor(l_run, 32));
    bf16* op = OX + qrow * 1024 + hx * 256 + 128 * dh + 4 * hh;
#pragma unroll
    for (int db = 0; db < 4; ++db)
#pragma unroll
        for (int g = 0; g < 4; ++g) { const unsigned lo = pk2(o[db][4 * g] * inv, o[db][4 * g + 1] * inv), hi = pk2(o[db][4 * g + 2] * inv, o[db][4 * g + 3] * inv);
            *(unsigned long long*)(op + 32 * db + 8 * g) = (unsigned long long)lo | ((unsigned long long)hi << 32); }
}

struct Args { const float* in[17]; float* out; unsigned char* ws; };
__global__ void __launch_bounds__(NWAVES * 64, 2) fwd_megakernel(Args args) {
    extern __shared__ __attribute__((aligned(16))) unsigned char lds[];
    LAS unsigned char* ldsp = (LAS unsigned char*)lds;
    const int wave = __builtin_amdgcn_readfirstlane((int)threadIdx.x >> 6);
    const int G = gridDim.x, bx = blockIdx.x, vcu = (G % 8 == 0) ? (bx % 8) * (G / 8) + bx / 8 : bx;
    const int gw = vcu * NWAVES + wave, NGW = G * NWAVES;
    unsigned char* ws = args.ws;
    gu32* ctl = (gu32*)(ws + WS_CTL);
    const float *x = args.in[0], *mem = args.in[1], *norm_mix = args.in[2], *w_in = args.in[3], *w_a = args.in[4], *w_b = args.in[5], *w_out = args.in[6], *norm_cross = args.in[7], *norm_mem = args.in[8],
                *w_xq = args.in[9], *w_xkv = args.in[10], *w_xo = args.in[11], *norm_ffn = args.in[12], *w_gate = args.in[13], *w_up = args.in[14], *w_down = args.in[15], *norm_final = args.in[16];
    float* out = args.out;
    bf16 *WIN = (bf16*)(ws + WS_WIN), *WAB = (bf16*)(ws + WS_WAB), *WOUT = (bf16*)(ws + WS_WOUT), *WXQ = (bf16*)(ws + WS_WXQ), *WXKV = (bf16*)(ws + WS_WXKV), *WXO = (bf16*)(ws + WS_WXO), *WGU = (bf16*)(ws + WS_WGU), *WDN = (bf16*)(ws + WS_WDN);
    bf16 *H = (bf16*)(ws + WS_H), *YAB = (bf16*)(ws + WS_YAB), *AK = (bf16*)(ws + WS_AK), *AVT = (bf16*)(ws + WS_AVT), *RQ = (bf16*)(ws + WS_RQ), *RK = (bf16*)(ws + WS_RK), *RKT = (bf16*)(ws + WS_RKT), *RVT = (bf16*)(ws + WS_RVT), *RG = (bf16*)(ws + WS_RG);
    bf16 *GR = (bf16*)out, *GS = (bf16*)out + (size_t)MTOK * DM;
    bf16 *ST = (bf16*)(ws + WS_ST), *QX = (bf16*)(ws + WS_QX), *MERGED = (bf16*)(ws + WS_MERGED), *OX = (bf16*)(ws + WS_OX), *XB = (bf16*)(ws + WS_XB), *ACT = (bf16*)(ws + WS_ACT);
    bf16 *MEMN = (bf16*)(ws + WS_MEMN), *KX = (bf16*)(ws + WS_KX), *VXT = (bf16*)(ws + WS_VXT);
    float *X1 = (float*)(ws + WS_X1), *SSQ1 = (float*)(ws + WS_SSQ1), *SSQ2 = (float*)(ws + WS_SSQ2), *SSQ3 = (float*)(ws + WS_SSQ3), *KMEAN = (float*)(ws + WS_KMEAN), *T64 = (float*)(ws + WS_T64), *T128 = (float*)(ws + WS_T128);

    for (int u = threadIdx.x; u < (LDS_BYTES - LDSCTL_OFF) / 4; u += NWAVES * 64) ((LAS unsigned*)(ldsp + LDSCTL_OFF))[u] = 0u;
    __syncthreads();
    XcdBarrier bar = xcd_barrier_post((unsigned*)(ctl + CW_BAR), (volatile LAS unsigned*)(ldsp + MISC_OFF) + 8);
#define GRID_BAR() xcd_barrier(bar)

    {
        const int lane = lane_id_v();
        LAS float* scr = (LAS float*)(ldsp + RING_OFF + wave * 16384);
        constexpr int I_IN = 16 * (INC / 32), I_A = 8 * 32, I_B = 16 * 32, I_SQ = 16 * 32, I_KV = 16 * 64, I_GU = 16 * (2 * DFF / 32), I_DN = (DFF / 64) * 32;
        constexpr int NITEMS = I_IN + I_A + I_B + 3 * I_SQ + I_KV + I_GU + I_DN;
        for (int it = gw; it < NITEMS; it += NGW) {
            int q = it;
            if (q < I_IN) { p0_transpose_item(w_in, w_in, INC, INC, 1, WIN, 1024, 0, scr, q, lane); continue; } q -= I_IN;
            if (q < I_A) { p0_transpose_item(w_a, w_a, 1024, 1024, 0, WAB, 1536, 0, scr, q, lane); continue; } q -= I_A;
            if (q < I_B) { p0_transpose_item(w_b, w_b, 1024, 1024, 0, WAB, 1536, 512, scr, q, lane); continue; } q -= I_B;
            if (q < I_SQ) { p0_transpose_item(w_out, w_out, 1024, 1024, 0, WOUT, 1024, 0, scr, q, lane); continue; } q -= I_SQ;
            if (q < I_SQ) { p0_transpose_item(w_xq, w_xq, 1024, 1024, 0, WXQ, 1024, 0, scr, q, lane); continue; } q -= I_SQ;
            if (q < I_SQ) { p0_transpose_item(w_xo, w_xo, 1024, 1024, 0, WXO, 1024, 0, scr, q, lane); continue; } q -= I_SQ;
            if (q < I_KV) { p0_transpose_item(w_xkv, w_xkv, 2048, 2048, 0, WXKV, 1024, 0, scr, q, lane); continue; } q -= I_KV;
            if (q < I_GU) { p0_transpose_item(w_gate, w_up, DFF, 2 * DFF, 2, WGU, 1024, 0, scr, q, lane); continue; } q -= I_GU;
            p0_transpose_item(w_down, w_down, 1024, 1024, 0, WDN, DFF, 0, scr, q, lane);
        }
        for (int m = gw; m < MTOK; m += NGW) rms_row_to_bf16(x + (size_t)m * DM, norm_mix, H + (size_t)m * DM, lane);
        for (int m = gw; m < MMEM; m += NGW) rms_row_to_bf16(mem + (size_t)m * DM, norm_mem, MEMN + (size_t)m * DM, lane);
        for (int e = gw * 64 + lane; e < SEQ * 96; e += NGW * 64) {
            float c, s;
            if (e < SEQ * 32) { rope_cs(e >> 5, e & 31, 64, c, s); T64[2 * e] = c; T64[2 * e + 1] = s; }
            else { const int e2 = e - SEQ * 32; rope_cs(e2 >> 6, e2 & 63, 128, c, s); T128[2 * e2] = c; T128[2 * e2 + 1] = s; }
        }
    }
    GRID_BAR();

    {
        pg8::Gemm g{H, WIN, MTOK, INC, DM}; pg8::StaticOrder S; S.init(MTOK, INC, G, bx);
        pg8::EpiProj E{YAB, AK, AVT, RQ, RK, RKT, RVT, RG, GR, GS, KMEAN, T64, T128};
        pg8::gemm_phase<pg8::EpiProj, pg8::StaticOrder, true, true>(ldsp + RING_OFF, g, S, E, wave);
        pg8::Gemm g2{MEMN, WXKV, MMEM, 2048, DM}; pg8::StaticOrder S2; S2.init(MMEM, 2048, G, bx);
        pg8::EpiKVX E2{KX, VXT};
        pg8::gemm_phase<pg8::EpiKVX, pg8::StaticOrder, true, true>(ldsp + RING_OFF, g2, S2, E2, wave);
    }
    GRID_BAR();

    {
        constexpr unsigned NSCAN = BATCH * 4 * 8, NMOBA = BATCH * 8 * 16 * 8;
        for (;;) {
            unsigned idx = 0u;
            const int ln = lane_id_v();
            if (ln == 0) idx = __hip_atomic_fetch_add(ctl + CW_Q, 1u, RLX_AGENT);
            idx = (unsigned)__builtin_amdgcn_readfirstlane((int)idx);
            if (idx >= NSCAN + NMOBA) break;
            if (idx < NSCAN) { scan_item(RKT, RVT, ST, (int)(idx >> 5), (int)((idx >> 3) & 3), (int)(idx & 7), ln); }
            else { const unsigned k = idx - NSCAN; const int qb = 15 - (int)(k >> 9), rem = (int)(k & 511);
                moba_item(YAB, AK, AVT, KMEAN, rem >> 6, (rem >> 3) & 7, qb, rem & 7, ln); }
        }
    }
    GRID_BAR();

    for (int it = gw; it < BATCH * 4 * NCHUNK * 4; it += NGW) { const int ln = lane_id_v(); retc_item(RQ, RK, RVT, ST, RG, YAB, it >> 9, (it >> 7) & 3, (it >> 2) & 31, it & 3, ln); }
    GRID_BAR();

    {
        pg8::Gemm g{YAB, WAB, MTOK, DM, 1536}; pg8::StaticOrder S; S.init(MTOK, DM, G, bx);
        pg8::EpiMerge E{GR, GS, MERGED};
        pg8::gemm_phase<pg8::EpiMerge, pg8::StaticOrder, true, true>(ldsp + RING_OFF, g, S, E, wave);
    }
    GRID_BAR();

    {
        pg8::Gemm g{MERGED, WOUT, MTOK, DM, DM}; pg8::StaticOrder S; S.init(MTOK, DM, G, bx);
        pg8::EpiResid<true> E{x, X1, XB, norm_cross, SSQ1};
        pg8::gemm_phase<pg8::EpiResid<true>, pg8::StaticOrder, true, true>(ldsp + RING_OFF, g, S, E, wave);
    }
    GRID_BAR();

    {
        pg8::Gemm g{XB, WXQ, MTOK, DM, DM}; pg8::StaticOrder S; S.init(MTOK, DM, G, bx);
        pg8::EpiRowScale E{SSQ1, QX, 0.0625f * LOG2E};
        pg8::gemm_phase<pg8::EpiRowScale, pg8::StaticOrder, true, true>(ldsp + RING_OFF, g, S, E, wave);
    }
    GRID_BAR();

    for (int it = gw; it < BATCH * 4 * 128 * 2; it += NGW) { const int ln = lane_id_v(); xattn_item(QX, KX, VXT, OX, it >> 10, (it >> 8) & 3, (it >> 1) & 127, it & 1, ln); }
    GRID_BAR();

    {
        pg8::Gemm g{OX, WXO, MTOK, DM, DM}; pg8::StaticOrder S; S.init(MTOK, DM, G, bx);
        pg8::EpiResid<true> E{X1, X1, XB, norm_ffn, SSQ2};
        pg8::gemm_phase<pg8::EpiResid<true>, pg8::StaticOrder, true, true>(ldsp + RING_OFF, g, S, E, wave);
    }
    GRID_BAR();

    {
        pg8::Gemm g{XB, WGU, MTOK, 2 * DFF, DM}; pg8::StaticOrder S; S.init(MTOK, 2 * DFF, G, bx);
        pg8::EpiSwiGLU E{SSQ2, ACT};
        pg8::gemm_phase<pg8::EpiSwiGLU, pg8::StaticOrder, true, true>(ldsp + RING_OFF, g, S, E, wave);
    }
    GRID_BAR();

    {
        pg8::Gemm g{ACT, WDN, MTOK, DM, DFF}; pg8::StaticOrder S; S.init(MTOK, DM, G, bx);
        pg8::EpiResid<false> E{X1, out, nullptr, nullptr, SSQ3};
        pg8::gemm_phase<pg8::EpiResid<false>, pg8::StaticOrder, true, true>(ldsp + RING_OFF, g, S, E, wave);
    }
    GRID_BAR();

    {
        const unsigned bad = (__hip_atomic_load(ctl + CW_TMO, RLX_AGENT) != 0u) | (__hip_atomic_load(ctl + CW_BAR + XB_TMO, RLX_AGENT) != 0u);
        const int lane = lane_id_v();
        for (int m = gw; m < MTOK; m += NGW) {
            const float rs = pg8::row_rstd(SSQ3, m);
            GAS f32x4* xr = (GAS f32x4*)(out + (size_t)m * DM) + lane; const GAS f32x4* gr = (const GAS f32x4*)norm_final + lane;
#pragma unroll
            for (int j = 0; j < 4; ++j) { f32x4 v = xr[64 * j] * rs * gr[64 * j]; if (bad) v = (f32x4){__builtin_nanf(""), __builtin_nanf(""), __builtin_nanf(""), __builtin_nanf("")}; xr[64 * j] = v; }
        }
    }
}

extern "C" void kernel_launch(void* const* d_in, const int* in_sizes, int n_in, void* d_out, int out_size, void* d_ws, size_t ws_size, hipStream_t stream) {
    static int grid = 0;
    if (grid == 0) {
        if (n_in != 17 || in_sizes[0] != MTOK * DM || out_size != MTOK * DM || ws_size < WS_END) { fprintf(stderr, "kernel_launch: unexpected shapes (n_in %d, in0 %d, out %d, ws %zu); nothing launched\n", n_in, n_in > 0 ? in_sizes[0] : -1, out_size, ws_size); grid = -1; return; }
        int dev = 0, cus = 0, per_cu = 0;
        if (hipGetDevice(&dev) != hipSuccess || hipDeviceGetAttribute(&cus, hipDeviceAttributeMultiprocessorCount, dev) != hipSuccess) { grid = -1; return; }
        if (hipFuncSetAttribute((const void*)fwd_megakernel, hipFuncAttributeMaxDynamicSharedMemorySize, LDS_BYTES) != hipSuccess) { fprintf(stderr, "kernel_launch: hipFuncSetAttribute failed\n"); grid = -1; return; }
        if (hipOccupancyMaxActiveBlocksPerMultiprocessor(&per_cu, (const void*)fwd_megakernel, NWAVES * 64, LDS_BYTES) != hipSuccess || per_cu < 1) { fprintf(stderr, "kernel_launch: occupancy query says %d blocks per CU; nothing launched\n", per_cu); (void)hipGetLastError(); grid = -1; return; }
        grid = cus;
    }
    if (grid < 0) return;
    if (hipMemsetAsync((char*)d_ws + WS_CTL, 0, CTL_ZERO_BYTES, stream) != hipSuccess) { fprintf(stderr, "kernel_launch: hipMemsetAsync failed\n"); return; }
    Args a{};
    for (int i = 0; i < 17; ++i) a.in[i] = (const float*)d_in[i];
    a.out = (float*)d_out; a.ws = (unsigned char*)d_ws;
    void* kargs[] = {&a};
    const hipError_t le = hipLaunchCooperativeKernel((const void*)fwd_megakernel, dim3(grid), dim3(NWAVES * 64), kargs, LDS_BYTES, stream);
    if (le != hipSuccess) fprintf(stderr, "kernel_launch: cooperative launch failed: %s (grid %d)\n", hipGetErrorName(le), grid);
}
```

```cpp
#include <hip/hip_runtime.h>
#include <cstdio>
#include <cstdint>
namespace pg8 {
#define PG8_LAS __attribute__((address_space(3)))
typedef unsigned short bf16_t;
typedef short bf16x8 __attribute__((ext_vector_type(8)));
typedef float f32x4 __attribute__((ext_vector_type(4)));
typedef unsigned u32x4 __attribute__((ext_vector_type(4)));
constexpr int BM = 256, BK = 64, HALF = 128, HTB = HALF * BK * 2  , STAGE_BYTES = 8 * HTB, NXCD = 8, WGM = 4;

__host__ __device__ __forceinline__ int lds_byte(int r, int c) { const int st = (r >> 4) * 2 + (c >> 5), rr = r & 15, cc = c & 31, ob = rr * 64 + cc * 2; return st * 1024 + (ob ^ (((ob >> 9) & 1) << 5)); }
__host__ __device__ __forceinline__ void stage_rc(int b, int& R, int& C) { const int st = b / 1024, sb = b % 1024, swz = sb ^ (((sb >> 9) & 1) << 5); R = (st >> 1) * 16 + swz / 64; C = (st & 1) * 32 + (swz % 64) / 2; }
__host__ __device__ __forceinline__ int perm32(int rho) { const int n = rho >> 4, i = rho & 15; return 8 * (i >> 2) + 4 * n + (i & 3); }

struct Unit { int pm, pn; };
struct Gemm { const bf16_t* A; const bf16_t* Bt; int M, N, K; int ablk = 0; };

struct StaticOrder {
    int nM, nN, nwg, G, c;
    __host__ __device__ void init(int M, int N, int G_, int c_) { nM = M / BM; nN = N / BM; nwg = nM * nN; G = G_; c = c_; }
    __host__ __device__ bool next(int i, Unit& u) const {
        const long L = (long)i * G + c; if (L >= nwg) return false;
        int wgid = (int)L; { const int q = nwg / NXCD, r = nwg % NXCD, xcd = wgid % NXCD, off = wgid / NXCD; wgid = (xcd < r ? xcd * (q + 1) : r * (q + 1) + (xcd - r) * q) + off; }
        const int nig = WGM * nN, gid = wgid / nig, fm = gid * WGM, gsz = (nM - fm) < WGM ? (nM - fm) : WGM;
        u.pm = fm + ((wgid % nig) % gsz); u.pn = (wgid % nig) / gsz; return true;
    }
    __device__ __forceinline__ void a_ready(const Unit&) const {}
    __device__ __forceinline__ void done(const Unit&) const {}
};


template <int MODE> struct StaticOrderMap {
    StaticOrder base;
    __device__ __forceinline__ bool next(int i, Unit& u) const { if (!base.next(i, u)) return false;
        if (MODE == 0) u.pn = u.pn < 4 ? u.pn : (u.pn < 8 ? u.pn + 2 : u.pn + 6); else u.pm = u.pm < 2 ? u.pm + 4 : u.pm + 8;
        return true; }
    __device__ __forceinline__ void a_ready(const Unit&) const {}
    __device__ __forceinline__ void done(const Unit&) const {}
};
struct OneUnit {
    int pm, pn;
    __device__ __forceinline__ bool next(int i, Unit& u) const { if (i != 0) return false; u.pm = pm; u.pn = pn; return true; }
    __device__ __forceinline__ void a_ready(const Unit&) const {}
    __device__ __forceinline__ void done(const Unit&) const {}
};
typedef unsigned u32x2 __attribute__((ext_vector_type(2)));
typedef float f32x2_t __attribute__((ext_vector_type(2))); typedef __bf16 bf16x2_t __attribute__((ext_vector_type(2)));
__device__ __forceinline__ unsigned pk2(float lo, float hi) { const f32x2_t v = {lo, hi}; const bf16x2_t b = __builtin_convertvector(v, bf16x2_t); return __builtin_bit_cast(unsigned, b); }
__device__ __forceinline__ unsigned f2bf(float f) { return pk2(f, 0.f) & 0xffffu; }
__device__ __forceinline__ float bflo(unsigned w) { return __builtin_bit_cast(float, w << 16); }
__device__ __forceinline__ float bfhi(unsigned w) { return __builtin_bit_cast(float, w & 0xffff0000u); }
__device__ __forceinline__ u32x2 pk4(f32x4 v) { u32x2 w; w.x = pk2(v[0], v[1]); w.y = pk2(v[2], v[3]); return w; }
__device__ __forceinline__ f32x4 unpk4(u32x2 w) { return (f32x4){bflo(w.x), bfhi(w.x), bflo(w.y), bfhi(w.y)}; }
__device__ __forceinline__ float lg2gamma(int h) { return h == 0 ? -0.04580368961312479f : (h == 1 ? -0.02272007650008353f : (h == 2 ? -0.011315313227834146f : -0.005646563141142063f)); }
__device__ __forceinline__ float sigmoidf_(float v) { return __builtin_amdgcn_rcpf(1.0f + __expf(-v)); }
constexpr int SEQ_ = 4096, DM_ = 1024;

__device__ __forceinline__ u32x4 pk8(f32x4 a, f32x4 b) { u32x4 w; w.x = pk2(a[0], a[1]); w.y = pk2(a[2], a[3]); w.z = pk2(b[0], b[1]); w.w = pk2(b[2], b[3]); return w; }
__device__ __forceinline__ f32x4 unlo(u32x4 w) { return (f32x4){bflo(w.x), bfhi(w.x), bflo(w.y), bfhi(w.y)}; }
__device__ __forceinline__ f32x4 unhi(u32x4 w) { return (f32x4){bflo(w.z), bfhi(w.z), bflo(w.w), bfhi(w.w)}; }
__device__ __forceinline__ size_t yab_idx(size_t t, int c) { return ((t >> 8) * 24 + (size_t)(c >> 6)) * 16384 + (t & 255) * 64 + (c & 63); }
struct EpiProj {
    static constexpr bool PERM = false, AFTER_DRAIN = false; static constexpr int MID_T = 0;
    bf16_t *YAB, *AK, *AVT, *RQ, *RK, *RKT, *RVT, *RG, *GR, *GS; float* KMEAN; const float* T64; const float* T128;
    __device__ __forceinline__ void mid(f32x4 (&)[2][2][4][2], const Unit&, int, int, int, int) const {}
    __device__ __forceinline__ void operator()(const f32x4 (&acc)[2][2][4][2], const Unit& u, int wr, int wc, int fr, int fq) const {
        const int pn = u.pn, rowb = u.pm * BM + wr * 64 + fr, b = u.pm >> 4;
        if (pn < 4 || (pn >= 6 && pn < 10)) {
            const bool is64 = pn < 4; const int rt = pn & 1, kind = is64 ? (pn >> 1) : (((pn - 6) >> 1) + 2);
            const int f0 = (is64 ? 16 * (wc & 1) : 16 * wc) + 4 * fq;
            f32x4 ks[2][2];
#pragma unroll
            for (int bj = 0; bj < 2; ++bj) { ks[bj][0] = (f32x4){0.f, 0.f, 0.f, 0.f}; ks[bj][1] = (f32x4){0.f, 0.f, 0.f, 0.f}; }
            f32x4 tcs[2][4][2];
#pragma unroll
            for (int ai = 0; ai < 2; ++ai)
#pragma unroll
                for (int m = 0; m < 4; ++m) { const int pos_ = (rowb + ai * HALF + m * 16) & (SEQ_ - 1); const float* tp_ = is64 ? (T64 + ((size_t)pos_ * 32 + f0) * 2) : (T128 + ((size_t)pos_ * 64 + f0) * 2);
                    tcs[ai][m][0] = *(const f32x4*)tp_; tcs[ai][m][1] = *(const f32x4*)(tp_ + 4); }
#pragma unroll
            for (int ai = 0; ai < 2; ++ai)
#pragma unroll
                for (int m = 0; m < 4; ++m) {
                    const int row = rowb + ai * HALF + m * 16, pos = row & (SEQ_ - 1);
                    const f32x4 cs0 = tcs[ai][m][0], cs1 = tcs[ai][m][1];
                    const float co[4] = {cs0[0], cs0[2], cs1[0], cs1[2]}, si[4] = {cs0[1], cs0[3], cs1[1], cs1[3]};
#pragma unroll
                    for (int bj = 0; bj < 2; ++bj) {
                        const f32x4 x1 = acc[ai][bj][m][0], x2 = acc[ai][bj][m][1]; f32x4 y1, y2;
#pragma unroll
                        for (int i = 0; i < 4; ++i) { y1[i] = x1[i] * co[i] - x2[i] * si[i]; y2[i] = x2[i] * co[i] + x1[i] * si[i]; }
                        const int rc = rt * 256 + bj * HALF + wc * 32 + 8 * fq;
                        bf16_t* dst = (kind == 0) ? (YAB + yab_idx((size_t)row, rc)) : (kind == 1) ? (AK + ((size_t)(b * 8 + (rc >> 6)) * SEQ_ + pos) * 64 + (rc & 63))
                                                  : ((kind == 2 ? RQ : RK) + ((size_t)(b * 4 + (rc >> 7)) * SEQ_ + pos) * 128 + (rc & 127));
                        *(u32x4*)dst = pk8(y1, y2);
                        if (kind == 1) { ks[bj][0] += y1; ks[bj][1] += y2; }
                        if (kind == 3) {
                            const int hh = rt * 2 + bj; const float kd = __builtin_amdgcn_exp2f((float)(127 - (pos & 127)) * lg2gamma(hh));
                            bf16_t* tb = RKT + (((size_t)(b * 4 + hh) * 32 + (pos >> 7)) * 128 + wc * 32 + 8 * fq) * 128 + (pos & 127);
#pragma unroll
                            for (int i = 0; i < 4; ++i) { tb[i * 128] = (bf16_t)f2bf(y1[i] * kd); tb[(4 + i) * 128] = (bf16_t)f2bf(y2[i] * kd); }
                        }
                    }
                }
            if (kind == 1) {
                const int blk = u.pm & 15;
#pragma unroll
                for (int bj = 0; bj < 2; ++bj)
#pragma unroll
                    for (int n = 0; n < 2; ++n)
#pragma unroll
                        for (int i = 0; i < 4; ++i) {
                            float s = ks[bj][n][i];
                            s += __shfl_xor(s, 1); s += __shfl_xor(s, 2); s += __shfl_xor(s, 4); s += __shfl_xor(s, 8);
                            if (fr == 0) atomicAdd(KMEAN + (size_t)(b * 16 + blk) * 512 + rt * 256 + bj * HALF + wc * 32 + 8 * fq + 4 * n + i, s);
                        }
            }
        } else if (pn < 18) {
            const int rt = pn - 14;
#pragma unroll
            for (int ai = 0; ai < 2; ++ai)
#pragma unroll
                for (int m = 0; m < 4; ++m) {
                    const int row = rowb + ai * HALF + m * 16;
#pragma unroll
                    for (int bj = 0; bj < 2; ++bj) {
                        const int rc = rt * 256 + bj * HALF + wc * 32 + 8 * fq; f32x4 v0 = acc[ai][bj][m][0], v1 = acc[ai][bj][m][1];
#pragma unroll
                        for (int i = 0; i < 4; ++i) { v0[i] = v0[i] * sigmoidf_(v0[i]); v1[i] = v1[i] * sigmoidf_(v1[i]); }
                        *(u32x4*)(RG + (size_t)row * 1024 + rc) = pk8(v0, v1);
                    }
                }
        } else {
            const int q = pn - 18;
#pragma unroll
            for (int ai = 0; ai < 2; ++ai)
#pragma unroll
                for (int m = 0; m < 4; ++m) {
                    const int row = rowb + ai * HALF + m * 16; unsigned g16[8];
#pragma unroll
                    for (int bj = 0; bj < 2; ++bj) { const f32x4 ga = acc[ai][bj][m][0], gb = acc[ai][bj][m][1];
#pragma unroll
                        for (int i = 0; i < 4; ++i) { const float sa = 255.0f * __builtin_amdgcn_rcpf(1.0f + __expf(-ga[i])), sb = 255.0f * __builtin_amdgcn_rcpf(1.0f + __expf(-gb[i]));
                            const unsigned qa = (unsigned)(sa + 0.5f), qb = (unsigned)(sb + 0.5f); g16[4 * bj + i] = qa | ((qb < 1u ? 1u : qb) << 8); } }
                    const int cg = 128 * q + 32 * wc + 8 * fq;
                    u32x4 w; w.x = g16[0] | (g16[1] << 16); w.y = g16[2] | (g16[3] << 16); w.z = g16[4] | (g16[5] << 16); w.w = g16[6] | (g16[7] << 16);
                    *(u32x4*)(GR + (size_t)row * 1024 + cg) = w;
                }
        }
    }
};

struct EpiVT {
    static constexpr bool PERM = true, AFTER_DRAIN = false; static constexpr int MID_T = 0;
    bf16_t *AVT, *RVT;
    __device__ __forceinline__ void mid(f32x4 (&)[2][2][4][2], const Unit&, int, int, int, int) const {}
    __device__ __forceinline__ void operator()(const f32x4 (&acc)[2][2][4][2], const Unit& u, int wr, int wc, int fr, int fq) const {
        const bool isa = u.pm < 6; const int rt = isa ? u.pm - 4 : u.pm - 10;
#pragma unroll
        for (int ai = 0; ai < 2; ++ai)
#pragma unroll
            for (int m = 0; m < 4; ++m) {
                const int rc = rt * 256 + ai * HALF + wr * 64 + 32 * (m >> 1) + 8 * (fr >> 2) + 4 * (m & 1) + (fr & 3);
#pragma unroll
                for (int bj = 0; bj < 2; ++bj) {
                    const int t = u.pn * BM + bj * HALF + wc * 32 + 8 * fq, b = t >> 12, pos = t & (SEQ_ - 1);
                    bf16_t* dst = isa ? (AVT + (((size_t)(b * 8 + (rc >> 6)) * 64 + (pos >> 6)) * 64 + (rc & 63)) * 64 + (pos & 63)) : (RVT + (((size_t)(b * 4 + (rc >> 8)) * 32 + (pos >> 7)) * 256 + (rc & 255)) * 128 + (pos & 127));
                    *(u32x4*)dst = pk8(acc[ai][bj][m][0], acc[ai][bj][m][1]);
                }
            }
    }
};

struct EpiKVX {
    static constexpr bool PERM = false, AFTER_DRAIN = false; static constexpr int MID_T = 0;
    bf16_t *KX, *VXT;
    __device__ __forceinline__ void mid(f32x4 (&)[2][2][4][2], const Unit&, int, int, int, int) const {}
    __device__ __forceinline__ void operator()(const f32x4 (&acc)[2][2][4][2], const Unit& u, int wr, int wc, int fr, int fq) const {
        const int pn = u.pn, b = u.pm;
#pragma unroll
        for (int ai = 0; ai < 2; ++ai)
#pragma unroll
            for (int m = 0; m < 4; ++m) {
                const int mt = ai * HALF + wr * 64 + m * 16 + fr;
#pragma unroll
                for (int bj = 0; bj < 2; ++bj) {
                    const int cc = bj * HALF + wc * 32 + 8 * fq;
                    if (pn < 4) *(u32x4*)(KX + ((size_t)(b * 4 + pn) * 256 + mt) * 256 + cc) = pk8(acc[ai][bj][m][0], acc[ai][bj][m][1]);
                    else {
#pragma unroll
                        for (int n = 0; n < 2; ++n) { bf16_t* tb = VXT + (((size_t)(b * 4 + (pn - 4)) * 4 + (mt >> 6)) * 256 + cc + 4 * n) * 64 + (mt & 63); const f32x4 v = acc[ai][bj][m][n];
#pragma unroll
                            for (int i = 0; i < 4; ++i) tb[i * 64] = (bf16_t)f2bf(v[i]); } }
                }
            }
    }
};

__device__ __forceinline__ f32x4 gratio(unsigned a, unsigned b) { return (f32x4){(float)(a & 0xffu) * __builtin_amdgcn_rcpf((float)((a >> 8) & 0xffu)), (float)((a >> 16) & 0xffu) * __builtin_amdgcn_rcpf((float)(a >> 24)),
                                                                                       (float)(b & 0xffu) * __builtin_amdgcn_rcpf((float)((b >> 8) & 0xffu)), (float)((b >> 16) & 0xffu) * __builtin_amdgcn_rcpf((float)(b >> 24))}; }
__device__ __forceinline__ f32x4 gsb(unsigned a, unsigned b) { const float k = 1.0f / 255.0f; return (f32x4){(float)((a >> 8) & 0xffu) * k, (float)(a >> 24) * k, (float)((b >> 8) & 0xffu) * k, (float)(b >> 24) * k}; }
struct EpiMerge {
    static constexpr bool PERM = false, AFTER_DRAIN = false; static constexpr int MID_T = 8;
    const bf16_t *GR, *GS; bf16_t* OUT;
    __device__ __forceinline__ void load_gates(u32x4 (&g)[4][2], int ai, const Unit& u, int wr, int wc, int fr, int fq) const {
#pragma unroll
        for (int m = 0; m < 4; ++m)
#pragma unroll
            for (int bj = 0; bj < 2; ++bj) g[m][bj] = *(const u32x4*)(GR + (size_t)(u.pm * BM + ai * HALF + wr * 64 + m * 16 + fr) * 1024 + u.pn * BM + bj * HALF + wc * 32 + 8 * fq);
    }
    __device__ __forceinline__ void mid(f32x4 (&acc)[2][2][4][2], const Unit& u, int wr, int wc, int fr, int fq) const {
#pragma unroll
        for (int ai = 0; ai < 2; ++ai)
#pragma unroll
            for (int mp = 0; mp < 2; ++mp) {
                u32x4 g[2][2];
#pragma unroll
                for (int mm = 0; mm < 2; ++mm)
#pragma unroll
                    for (int bj = 0; bj < 2; ++bj) g[mm][bj] = *(const u32x4*)(GR + (size_t)(u.pm * BM + ai * HALF + wr * 64 + (2 * mp + mm) * 16 + fr) * 1024 + u.pn * BM + bj * HALF + wc * 32 + 8 * fq);
#pragma unroll
                for (int mm = 0; mm < 2; ++mm)
#pragma unroll
                    for (int bj = 0; bj < 2; ++bj) { acc[ai][bj][2 * mp + mm][0] *= gratio(g[mm][bj].x, g[mm][bj].y); acc[ai][bj][2 * mp + mm][1] *= gratio(g[mm][bj].z, g[mm][bj].w); }
            }
    }
    __device__ __forceinline__ void operator()(const f32x4 (&acc)[2][2][4][2], const Unit& u, int wr, int wc, int fr, int fq) const {
#pragma unroll
        for (int ai = 0; ai < 2; ++ai) {
            u32x4 g[4][2]; load_gates(g, ai, u, wr, wc, fr, fq);
#pragma unroll
            for (int m = 0; m < 4; ++m) {
                const int row = u.pm * BM + ai * HALF + wr * 64 + m * 16 + fr;
#pragma unroll
                for (int bj = 0; bj < 2; ++bj) { const int c = u.pn * BM + bj * HALF + wc * 32 + 8 * fq;
                    *(u32x4*)(OUT + (size_t)row * 1024 + c) = pk8(acc[ai][bj][m][0] * gsb(g[m][bj].x, g[m][bj].y), acc[ai][bj][m][1] * gsb(g[m][bj].z, g[m][bj].w)); }
            }
        }
    }
};

template <bool BASE_BF16, bool OUT_BF16> struct EpiResid {
    static constexpr bool PERM = false, AFTER_DRAIN = false; static constexpr int MID_T = 0;
    const void* base; void* out; float* SSQ;
    __device__ __forceinline__ void mid(f32x4 (&)[2][2][4][2], const Unit&, int, int, int, int) const {}
    __device__ __forceinline__ void operator()(const f32x4 (&acc)[2][2][4][2], const Unit& u, int wr, int wc, int fr, int fq) const {
#pragma unroll
        for (int ai = 0; ai < 2; ++ai) {
            f32x4 b0[4][2], b1[4][2];
#pragma unroll
            for (int m = 0; m < 4; ++m)
#pragma unroll
                for (int bj = 0; bj < 2; ++bj) { const size_t off = (size_t)(u.pm * BM + ai * HALF + wr * 64 + m * 16 + fr) * DM_ + u.pn * BM + bj * HALF + wc * 32 + 8 * fq;
                    if (BASE_BF16) { const u32x4 w = *(const u32x4*)((const bf16_t*)base + off); b0[m][bj] = unlo(w); b1[m][bj] = unhi(w); }
                    else { b0[m][bj] = *(const f32x4*)((const float*)base + off); b1[m][bj] = *(const f32x4*)((const float*)base + off + 4); } }
#pragma unroll
            for (int m = 0; m < 4; ++m) {
                const int row = u.pm * BM + ai * HALF + wr * 64 + m * 16 + fr; float ss = 0.f;
#pragma unroll
                for (int bj = 0; bj < 2; ++bj) { const int c = u.pn * BM + bj * HALF + wc * 32 + 8 * fq; const size_t off = (size_t)row * DM_ + c;
                    const f32x4 x0 = b0[m][bj] + acc[ai][bj][m][0], x1 = b1[m][bj] + acc[ai][bj][m][1];
                    ss += ((x0[0] * x0[0] + x0[1] * x0[1]) + (x0[2] * x0[2] + x0[3] * x0[3])) + ((x1[0] * x1[0] + x1[1] * x1[1]) + (x1[2] * x1[2] + x1[3] * x1[3]));
                    if (OUT_BF16) *(u32x4*)((bf16_t*)out + off) = pk8(x0, x1); else { *(f32x4*)((float*)out + off) = x0; *(f32x4*)((float*)out + off + 4) = x1; } }
                ss += __shfl_xor(ss, 16); ss += __shfl_xor(ss, 32);
                if (fq == 0) SSQ[(size_t)row * 16 + u.pn * 4 + wc] = ss;
            }
        }
    }
};
__device__ __forceinline__ float row_rstd(const float* SSQ, int row) {
    const f32x4 a = *(const f32x4*)(SSQ + (size_t)row * 16), b = *(const f32x4*)(SSQ + (size_t)row * 16 + 4), c = *(const f32x4*)(SSQ + (size_t)row * 16 + 8), d = *(const f32x4*)(SSQ + (size_t)row * 16 + 12);
    const float s = (((a[0] + a[1]) + (a[2] + a[3])) + ((b[0] + b[1]) + (b[2] + b[3]))) + (((c[0] + c[1]) + (c[2] + c[3])) + ((d[0] + d[1]) + (d[2] + d[3])));
    return __builtin_amdgcn_rsqf(s * (1.0f / 1024.0f) + 1e-6f);
}
__device__ __forceinline__ void rows_rstd(const float* SSQ, const Unit& u, int wr, int fr, int fq, float (&rs)[2][4]) {
    f32x4 p[2][4];
#pragma unroll
    for (int ai = 0; ai < 2; ++ai)
#pragma unroll
        for (int m = 0; m < 4; ++m) p[ai][m] = *(const f32x4*)(SSQ + (size_t)(u.pm * BM + ai * HALF + wr * 64 + m * 16 + fr) * 16 + 4 * fq);
#pragma unroll
    for (int ai = 0; ai < 2; ++ai)
#pragma unroll
        for (int m = 0; m < 4; ++m) { float t = (p[ai][m][0] + p[ai][m][1]) + (p[ai][m][2] + p[ai][m][3]); t += __shfl_xor(t, 16); t += __shfl_xor(t, 32); rs[ai][m] = __builtin_amdgcn_rsqf(t * (1.0f / 1024.0f) + 1e-6f); }
}
struct EpiRowScale {
    static constexpr bool PERM = false, AFTER_DRAIN = false; static constexpr int MID_T = 0;
    const float* SSQ; bf16_t* OUT; float scale;
    __device__ __forceinline__ void mid(f32x4 (&)[2][2][4][2], const Unit&, int, int, int, int) const {}
    __device__ __forceinline__ void operator()(const f32x4 (&acc)[2][2][4][2], const Unit& u, int wr, int wc, int fr, int fq) const {
        float rsv[2][4]; rows_rstd(SSQ, u, wr, fr, fq, rsv);
#pragma unroll
        for (int ai = 0; ai < 2; ++ai)
#pragma unroll
            for (int m = 0; m < 4; ++m) {
                const int row = u.pm * BM + ai * HALF + wr * 64 + m * 16 + fr; const float rs = rsv[ai][m] * scale;
#pragma unroll
                for (int bj = 0; bj < 2; ++bj) { const int c = u.pn * BM + bj * HALF + wc * 32 + 8 * fq; *(u32x4*)(OUT + (size_t)row * DM_ + c) = pk8(acc[ai][bj][m][0] * rs, acc[ai][bj][m][1] * rs); }
            }
    }
};
struct EpiSwiGLU {
    static constexpr bool PERM = false, AFTER_DRAIN = false; static constexpr int MID_T = 0;
    const float* SSQ; bf16_t* OUT;
    __device__ __forceinline__ void mid(f32x4 (&)[2][2][4][2], const Unit&, int, int, int, int) const {}
    __device__ __forceinline__ void operator()(const f32x4 (&acc)[2][2][4][2], const Unit& u, int wr, int wc, int fr, int fq) const {
        float rsv[2][4]; rows_rstd(SSQ, u, wr, fr, fq, rsv);
#pragma unroll
        for (int ai = 0; ai < 2; ++ai)
#pragma unroll
            for (int m = 0; m < 4; ++m) {
                const int row = u.pm * BM + ai * HALF + wr * 64 + m * 16 + fr; const float rs = rsv[ai][m]; f32x4 a[2];
#pragma unroll
                for (int bj = 0; bj < 2; ++bj) { const f32x4 g = acc[ai][bj][m][0] * rs, up = acc[ai][bj][m][1] * rs;
#pragma unroll
                    for (int i = 0; i < 4; ++i) a[bj][i] = g[i] * sigmoidf_(g[i]) * up[i]; }
                *(u32x4*)(OUT + (size_t)row * 2816 + 128 * u.pn + 32 * wc + 8 * fq) = pk8(a[0], a[1]);
            }
    }
};

template <class Epi, class Sched, bool ALIGN_EPI = false, bool SP2 = false>
__device__ __forceinline__ void gemm_phase(PG8_LAS unsigned char* lds, const Gemm g, const Sched& S, const Epi& E, int wave_s) {
    int tid_; asm volatile("v_mbcnt_lo_u32_b32 %0, -1, 0\n\tv_mbcnt_hi_u32_b32 %0, -1, %0" : "=v"(tid_)); tid_ += wave_s * 64;
    const int tid = tid_, wid = __builtin_amdgcn_readfirstlane(tid >> 6), lane = tid & 63, wr = wid >> 2, wc = wid & 3, fr = lane & 15, fq = lane >> 4;
    const int K = g.K, nt = K / BK;
    unsigned voffA[2], voffB[2];
#pragma unroll
    for (int i = 0; i < 2; ++i) { int R, C; stage_rc(tid * 16 + i * 8192, R, C); const int Rb = Epi::PERM ? ((R & ~31) + perm32(R & 31)) : R;
        voffA[i] = g.ablk ? (unsigned)(R * BK + C) * 2u : (unsigned)(R * K + C) * 2u; voffB[i] = (unsigned)(Rb * K + C) * 2u; }
    const size_t kstep = (size_t)(BK * 2);
    const size_t hstep = (size_t)HALF * K * 2;
    const size_t tstep = 2 * hstep;
    const size_t kstepA = g.ablk ? (size_t)BM * BK * 2 : kstep, hstepA = g.ablk ? (size_t)HALF * BK * 2 : hstep, tstepA = g.ablk ? (size_t)BM * K * 2 : tstep;
    const unsigned ldsw = (unsigned)wid * 1024u;
    const int aoff = lds_byte(wr * 64 + fr, fq * 8), boff = lds_byte(wc * 32 + fr, fq * 8);
#define PG8_SA(b, h) (((b) * 2 + (h)) * HTB)
#define PG8_SB(b, h) ((4 + (b) * 2 + (h)) * HTB)
#define PG8_STAGE(bufoff, gbase, voff) do { _Pragma("unroll") for (int _i = 0; _i < 2; ++_i) \
        __builtin_amdgcn_global_load_lds((const unsigned*)((const char*)(gbase) + (voff)[_i]), (PG8_LAS unsigned*)(lds + (bufoff) + ldsw + _i * 8192), 16, 0, 0); } while (0)
#define PG8_LDA(dst, b, h) do { _Pragma("unroll") for (int m = 0; m < 4; ++m) _Pragma("unroll") for (int k = 0; k < 2; ++k) dst[m][k] = *(const PG8_LAS bf16x8*)(lds + PG8_SA(b, h) + aoff + m * 2048 + k * 1024); } while (0)
#define PG8_LDB(dst, b, h) do { _Pragma("unroll") for (int n = 0; n < 2; ++n) _Pragma("unroll") for (int k = 0; k < 2; ++k) dst[n][k] = *(const PG8_LAS bf16x8*)(lds + PG8_SB(b, h) + boff + n * 2048 + k * 1024); } while (0)
#define PG8_MMA(ai, bj, At, Bt) do { __builtin_amdgcn_s_setprio(1); _Pragma("unroll") for (int m = 0; m < 4; ++m) _Pragma("unroll") for (int n = 0; n < 2; ++n) _Pragma("unroll") for (int k = 0; k < 2; ++k) \
        acc[ai][bj][m][n] = __builtin_amdgcn_mfma_f32_16x16x32_bf16(Bt[n][k], At[m][k], acc[ai][bj][m][n], 0, 0, 0); __builtin_amdgcn_s_setprio(0); } while (0)
#define PG8_WAIT_V(n) asm volatile("s_waitcnt vmcnt(" #n ")" ::: "memory")
#define PG8_WAIT_L(n) asm volatile("s_waitcnt lgkmcnt(" #n ")" ::: "memory")
#define PG8_BAR __builtin_amdgcn_s_barrier()
#define PG8_SCHED __builtin_amdgcn_sched_barrier(0)
    Unit cur, nxt; int ui = 0;
    if (!S.next(0, cur)) return;
    f32x4 acc[2][2][4][2];
#pragma unroll
    for (int a = 0; a < 2; ++a)
#pragma unroll
        for (int b = 0; b < 2; ++b)
#pragma unroll
            for (int m = 0; m < 4; ++m)
#pragma unroll
                for (int n = 0; n < 2; ++n) acc[a][b][m][n] = (f32x4){0.f, 0.f, 0.f, 0.f};
    bf16x8 At[4][2], B0[2][2], B1[2][2];
    const char* cA = (const char*)g.A + (size_t)cur.pm * tstepA; const char* cB = (const char*)g.Bt + (size_t)cur.pn * tstep;
    S.a_ready(cur);
    if constexpr (SP2) {
        PG8_STAGE(PG8_SB(0, 0), cB, voffB); PG8_STAGE(PG8_SB(0, 1), cB + hstep, voffB); PG8_STAGE(PG8_SA(0, 0), cA, voffA); PG8_STAGE(PG8_SA(0, 1), cA + hstepA, voffA);
        if (wr == 1) PG8_BAR;
        PG8_WAIT_V(2); PG8_BAR;
        PG8_STAGE(PG8_SB(1, 0), cB + kstep, voffB); PG8_STAGE(PG8_SA(1, 0), cA + kstepA, voffA); PG8_STAGE(PG8_SB(1, 1), cB + hstep + kstep, voffB);
        PG8_WAIT_V(6); PG8_BAR;
    } else {
        PG8_STAGE(PG8_SB(0, 0), cB, voffB); PG8_STAGE(PG8_SA(0, 0), cA, voffA); PG8_STAGE(PG8_SB(0, 1), cB + hstep, voffB); PG8_STAGE(PG8_SA(0, 1), cA + hstepA, voffA);
        if (wr == 1) PG8_BAR;
        PG8_WAIT_V(4); PG8_BAR;
        PG8_STAGE(PG8_SB(1, 0), cB + kstep, voffB); PG8_STAGE(PG8_SA(1, 0), cA + kstepA, voffA); PG8_STAGE(PG8_SB(1, 1), cB + hstep + kstep, voffB);
        PG8_WAIT_V(6); PG8_BAR;
    }
    for (;;) {
        const bool has_next = S.next(ui + 1, nxt);
        const char* nA = has_next ? (const char*)g.A + (size_t)nxt.pm * tstepA : cA; const char* nB = has_next ? (const char*)g.Bt + (size_t)nxt.pn * tstep : cB;
        for (int t = 0; t < nt; t += 2) {
            const bool last = (t == nt - 2);
            if constexpr (Epi::MID_T > 0) { if (t == Epi::MID_T) E.mid(acc, cur, wr, wc, fr, fq); }
            const char* a1 = cA + (size_t)(t + 1) * kstepA;
            const char* a2 = last ? nA : cA + (size_t)(t + 2) * kstepA; const char* b2 = last ? nB : cB + (size_t)(t + 2) * kstep;
            const char* a3 = a2 + kstepA; const char* b3 = b2 + kstep;
            if (last && has_next) S.a_ready(nxt);
            if constexpr (SP2) {
            PG8_LDB(B0, 0, 0); PG8_LDB(B1, 0, 1); PG8_SCHED; PG8_LDA(At, 0, 0); PG8_STAGE(PG8_SA(1, 1), a1 + hstepA, voffA);
            PG8_WAIT_V(8); PG8_WAIT_L(0); PG8_BAR; PG8_MMA(0, 0, At, B0); PG8_MMA(0, 1, At, B1); PG8_BAR; PG8_SCHED;
            PG8_LDA(At, 0, 1); PG8_STAGE(PG8_SB(0, 0), b2, voffB); PG8_STAGE(PG8_SB(0, 1), b2 + hstep, voffB); PG8_STAGE(PG8_SA(0, 0), a2, voffA);
            PG8_WAIT_V(8); PG8_WAIT_L(0); PG8_BAR; PG8_MMA(1, 0, At, B0); PG8_MMA(1, 1, At, B1); PG8_BAR; PG8_SCHED;
            PG8_LDB(B0, 1, 0); PG8_LDB(B1, 1, 1); PG8_SCHED; PG8_LDA(At, 1, 0); PG8_STAGE(PG8_SA(0, 1), a2 + hstepA, voffA);
            PG8_WAIT_V(8); PG8_WAIT_L(0); PG8_BAR; PG8_MMA(0, 0, At, B0); PG8_MMA(0, 1, At, B1); PG8_BAR; PG8_SCHED;
            PG8_LDA(At, 1, 1); PG8_STAGE(PG8_SB(1, 0), b3, voffB); PG8_STAGE(PG8_SB(1, 1), b3 + hstep, voffB); PG8_STAGE(PG8_SA(1, 0), a3, voffA);
            PG8_WAIT_V(8); PG8_WAIT_L(0); PG8_BAR; PG8_MMA(1, 0, At, B0); PG8_MMA(1, 1, At, B1); PG8_BAR; PG8_SCHED;
            } else {
            PG8_LDB(B0, 0, 0); PG8_SCHED; PG8_LDA(At, 0, 0); PG8_STAGE(PG8_SA(1, 1), a1 + hstepA, voffA);
            PG8_WAIT_L(8); PG8_BAR; PG8_WAIT_L(0); PG8_MMA(0, 0, At, B0); PG8_BAR; PG8_SCHED;
            PG8_LDB(B1, 0, 1); PG8_STAGE(PG8_SB(0, 0), b2, voffB);
            PG8_BAR; PG8_WAIT_L(0); PG8_MMA(0, 1, At, B1); PG8_BAR;
            PG8_LDA(At, 0, 1); PG8_STAGE(PG8_SA(0, 0), a2, voffA);
            PG8_BAR; PG8_WAIT_L(0); PG8_MMA(1, 0, At, B0); PG8_BAR; PG8_SCHED;
            PG8_STAGE(PG8_SB(0, 1), b2 + hstep, voffB);
            PG8_WAIT_V(6); PG8_BAR; PG8_MMA(1, 1, At, B1); PG8_BAR;
            PG8_LDB(B0, 1, 0); PG8_SCHED; PG8_LDA(At, 1, 0); PG8_STAGE(PG8_SA(0, 1), a2 + hstepA, voffA);
            PG8_WAIT_L(8); PG8_BAR; PG8_WAIT_L(0); PG8_MMA(0, 0, At, B0); PG8_BAR; PG8_SCHED;
            PG8_LDB(B1, 1, 1); PG8_STAGE(PG8_SB(1, 0), b3, voffB);
            PG8_BAR; PG8_WAIT_L(0); PG8_MMA(0, 1, At, B1); PG8_BAR;
            PG8_LDA(At, 1, 1); PG8_STAGE(PG8_SA(1, 0), a3, voffA);
            PG8_BAR; PG8_WAIT_L(0); PG8_MMA(1, 0, At, B0); PG8_BAR; PG8_SCHED;
            PG8_STAGE(PG8_SB(1, 1), b3 + hstep, voffB);
            PG8_WAIT_V(6); PG8_BAR; PG8_MMA(1, 1, At, B1); PG8_BAR;
            }
        }
        if constexpr (ALIGN_EPI) { if (wr == 0) PG8_BAR; }
        if constexpr (!Epi::AFTER_DRAIN) { E(acc, cur, wr, wc, fr, fq); S.done(cur); }
        if (!has_next) break;
#pragma unroll
        for (int a = 0; a < 2; ++a)
#pragma unroll
            for (int b = 0; b < 2; ++b)
#pragma unroll
                for (int m = 0; m < 4; ++m)
#pragma unroll
                    for (int n = 0; n < 2; ++n) acc[a][b][m][n] = (f32x4){0.f, 0.f, 0.f, 0.f};
        cur = nxt; cA = nA; cB = nB; ++ui;
        if constexpr (ALIGN_EPI) { if (wr == 1) PG8_BAR; }
    }
    PG8_WAIT_V(0);
    if constexpr (!ALIGN_EPI) { if (wr == 0) PG8_BAR; }
    PG8_BAR;
    if constexpr (Epi::AFTER_DRAIN) { E.fused(acc, cur, wr, wc, fr, fq, lds, wid, lane); S.done(cur); }
#undef PG8_SA
#undef PG8_SB
#undef PG8_STAGE
#undef PG8_LDA
#undef PG8_LDB
#undef PG8_MMA
#undef PG8_WAIT_V
#undef PG8_WAIT_L
#undef PG8_BAR
#undef PG8_SCHED
}
}


constexpr int NWAVES = 8;
#ifndef PROBE_PHASE
#define PROBE_PHASE (-1)
#endif
constexpr int BATCH = 8, SEQ = 4096, DM = 1024, MTOK = BATCH * SEQ, MEML = 256, MMEM = BATCH * MEML;
constexpr int INC = 6656, DFF = 2816, NCHUNK = 32;
constexpr float EPS = 1e-6f, LOG2E = 1.4426950408889634f;
#define NEG_INF (-__builtin_inff())

constexpr size_t MiB = 1u << 20;
constexpr size_t WS_CTL = 0, WS_KMEAN = 256 * 1024, CTL_ZERO_BYTES = 512 * 1024;
constexpr size_t WS_T64 = 1 * MiB, WS_T128 = 2 * MiB, WS_MEMN = 4 * MiB, WS_KX = 8 * MiB, WS_VXT = 12 * MiB;
constexpr size_t WS_WIN = 16 * MiB, WS_WAB = 29 * MiB, WS_WOUT = 32 * MiB, WS_WXQ = 34 * MiB, WS_WXKV = 36 * MiB, WS_WXO = 40 * MiB, WS_WGU = 42 * MiB, WS_WDN = 53 * MiB;
constexpr size_t WS_H = 60 * MiB, WS_YAB = 124 * MiB, WS_AK = 220 * MiB, WS_AVT = 252 * MiB, WS_RQ = 284 * MiB, WS_RK = 316 * MiB, WS_RKT = 348 * MiB, WS_RVT = 380 * MiB, WS_RG = 444 * MiB, WS_END = 508 * MiB;
constexpr size_t WS_ST = WS_H, WS_QX = WS_H, WS_MERGED = WS_AK, WS_OX = WS_AK, WS_X1 = 284 * MiB, WS_SSQ1 = 412 * MiB, WS_SSQ2 = 414 * MiB, WS_SSQ3 = 416 * MiB, WS_XB = WS_RG, WS_ACT = 60 * MiB;
static_assert(WS_WDN + (size_t)DM * DFF * 2 <= WS_H && WS_ACT + (size_t)MTOK * DFF * 2 <= WS_X1 && WS_X1 + (size_t)MTOK * DM * 4 <= WS_SSQ1 && WS_SSQ3 + 2 * MiB <= WS_XB, "d_ws map");
constexpr int CW_TMO = 0, CW_CODE = 1, CW_BAR = 4096, CW_Q = 8192;

constexpr int RING_OFF = 0, RING_BYTES = 131072;
constexpr int LDSCTL_OFF = RING_BYTES, MISC_OFF = LDSCTL_OFF + 320;
constexpr int LDS_BYTES = 147456;

#define GAS __attribute__((address_space(1)))
#define LAS __attribute__((address_space(3)))
typedef unsigned short bf16;
typedef unsigned v4u __attribute__((ext_vector_type(4)));
typedef float f32x4 __attribute__((ext_vector_type(4)));
typedef short bf16x8 __attribute__((ext_vector_type(8)));
typedef GAS unsigned gu32;
typedef GAS unsigned long long gu64;
#define RLX_AGENT __ATOMIC_RELAXED, __HIP_MEMORY_SCOPE_AGENT
#define LDS_WAIT() asm volatile("s_waitcnt lgkmcnt(0)" ::: "memory")
#define VM_WAIT() asm volatile("s_waitcnt vmcnt(0)" ::: "memory")
__device__ __forceinline__ unsigned long long rt() { return __builtin_amdgcn_s_memrealtime(); }
__device__ __forceinline__ unsigned pk2(float lo, float hi) { return pg8::pk2(lo, hi); }
__device__ __forceinline__ unsigned f2bf(float f) { return pg8::f2bf(f); }

#define XB_TMO      128
#define XB_XCNT(j)  (256  + 64 * (j))
#define XB_XSUB(j)  (1280 + 64 * (j))
#define XB_XGEN(j)  (2304 + 64 * (j))
#define XB_TOP      3328
#define XB_TOPGEN   3392
#define XCD_BAR_WORDS 3456
#define XB_SPIN_CAP (1u << 18)

__device__ __forceinline__ unsigned xb_ld(unsigned* p)              { return __hip_atomic_load(p, __ATOMIC_RELAXED, __HIP_MEMORY_SCOPE_AGENT); }
__device__ __forceinline__ unsigned xb_add(unsigned* p, unsigned v) { return __hip_atomic_fetch_add(p, v, __ATOMIC_RELAXED, __HIP_MEMORY_SCOPE_AGENT); }
__device__ __forceinline__ unsigned xb_xcc_id() { return (unsigned)__builtin_amdgcn_s_getreg((3 << 11) | 20) & 0xFu; }
#define XB_SPIN(cond, bar) do { unsigned _sp = 0; while (cond) { __builtin_amdgcn_s_sleep(1); \
    if ((++_sp & 255u) == 0u) { if (xb_ld(&(bar)[XB_TMO])) break; if (_sp > XB_SPIN_CAP) { atomicAdd(&(bar)[XB_TMO], 1u); break; } } } } while (0)

struct XcdBarrier {
    unsigned* bar; unsigned x;
    volatile LAS unsigned* st;
};

__device__ __forceinline__ XcdBarrier xcd_barrier_post(unsigned* bar, volatile LAS unsigned* st) {
    XcdBarrier b; b.bar = bar; b.x = xb_xcc_id(); b.st = st;
    if (threadIdx.x == 0) (void)xb_add(&bar[XB_XCNT(b.x)], 1u);
    return b;
}
__device__ __forceinline__ void xcd_barrier_complete(unsigned* bar, unsigned x, unsigned& nloc, unsigned& nx) {
    const unsigned G = gridDim.x * gridDim.y * gridDim.z;
    unsigned sum, cnt, mine, sp = 0u;
    for (;;) {
        sum = 0u; cnt = 0u; mine = 0u;
#pragma unroll
        for (unsigned j = 0; j < 16; ++j) { const unsigned c = xb_ld(&bar[XB_XCNT(j)]); sum += c; cnt += (c > 0u) ? 1u : 0u; mine = (j == x) ? c : mine; }
        if (sum == G) break;
        __builtin_amdgcn_s_sleep(1);
        if ((++sp & 255u) == 0u) { if (xb_ld(&bar[XB_TMO])) break; if (sp > XB_SPIN_CAP) { atomicAdd(&bar[XB_TMO], 1u); break; } }
    }
    nloc = mine > 0u ? mine : 1u; nx = cnt > 0u ? cnt : 1u;
}

__device__ __forceinline__ void xcd_barrier(const XcdBarrier& b, bool leader_thread) {
    asm volatile("s_waitcnt vmcnt(0)" ::: "memory");
    __syncthreads();
    if (leader_thread) {
        unsigned* bar = b.bar;
        __builtin_amdgcn_s_waitcnt(0);
        unsigned nloc = b.st[0], nx = b.st[1];
        if (nloc == 0u) { xcd_barrier_complete(bar, b.x, nloc, nx); b.st[0] = nloc; b.st[1] = nx; }
        const unsigned old = xb_add(&bar[XB_XSUB(b.x)], 1u);
        const unsigned gen = old / nloc;
        if (old + 1u == (gen + 1u) * nloc) {
            __builtin_amdgcn_fence(__ATOMIC_RELEASE, "agent");
            asm volatile("s_waitcnt vmcnt(0)" ::: "memory");
            const unsigned og = xb_add(&bar[XB_TOP], 1u);
            const unsigned tg = og / nx;
            if (og + 1u == (tg + 1u) * nx) xb_add(&bar[XB_TOPGEN], 1u);
            else XB_SPIN(xb_ld(&bar[XB_TOPGEN]) == tg, bar);
            __builtin_amdgcn_fence(__ATOMIC_ACQUIRE, "agent");
            xb_add(&bar[XB_XGEN(b.x)], 1u);
            asm volatile("s_waitcnt vmcnt(0)" ::: "memory");
        } else {
            XB_SPIN(xb_ld(&bar[XB_XGEN(b.x)]) == gen, bar);
            __builtin_amdgcn_fence(__ATOMIC_ACQUIRE, "agent");
            asm volatile("s_waitcnt vmcnt(0)" ::: "memory");
        }
    }
    __syncthreads();
}

__device__ __forceinline__ int lane_id_v() { int l; asm volatile("v_mbcnt_lo_u32_b32 %0, -1, 0\n\tv_mbcnt_hi_u32_b32 %0, -1, %0" : "=v"(l)); return l; }
__device__ __forceinline__ float wave_sum(float v) {
#pragma unroll
    for (int o = 1; o < 64; o <<= 1) v += __shfl_xor(v, o);
    return v;
}
__device__ __forceinline__ void col_map(int kind, int p, int& which, int& col, float& sc) {
    const int j = p & 31, jn = j >> 4, jfq = (j >> 2) & 3, ji = j & 3, plain = (p & ~31) + 8 * jfq + 4 * jn + ji;
    which = 0; col = plain; sc = 1.0f;
    if (kind == 1) {
        const int pn = p >> 8, cp = p & 255;
        if (pn < 4) { const int rc = (pn & 1) * 256 + cp, hh = rc >> 6, oo = rc & 63, f = 16 * (oo >> 5) + (oo & 15), half = (oo >> 4) & 1; col = (pn >> 1) * 512 + hh * 64 + half * 32 + f; if (pn < 2) sc = 0.125f * LOG2E; }
        else if (pn < 6) { col = 1024 + (plain - 4 * 256); }
        else if (pn < 10) { const int rc = (pn & 1) * 256 + cp, hh = rc >> 7, oo = rc & 127, f = 16 * (oo >> 5) + (oo & 15), half = (oo >> 4) & 1; col = 1536 + ((pn - 6) >> 1) * 512 + hh * 128 + half * 64 + f; if (pn >= 8) sc = 0.08838834764831845f; }
        else if (pn < 18) { col = 2560 + (plain - 10 * 256); }
        else { const int q = pn - 18, bj = cp >> 7, wc = (cp >> 5) & 3; col = (jn ? 5632 : 4608) + 128 * q + 32 * wc + 8 * jfq + 4 * bj + ji; }
    } else if (kind == 2) {
        const int q = p >> 8, cp = p & 255, bj = cp >> 7, wc = (cp >> 5) & 3; which = jn; col = 128 * q + 32 * wc + 8 * jfq + 4 * bj + ji;
    }
}
__device__ __forceinline__ void p0_tile128(const float* s0, const float* s1, int N, int Np, int kind, bf16* WT, int ldt, int koff, LAS unsigned char* lds, int item, int tid, const float* gk = nullptr) {
    const int nblk = Np / 128, kb = item / nblk, nb = item % nblk, k0 = 128 * kb, n0 = 128 * nb, p4 = tid & 31, r0 = tid >> 5;
    int which, col; float sc; col_map(kind, n0 + 4 * p4, which, col, sc);
    const float* src = (which ? s1 : s0) + col;
    f32x4 v[8];
#pragma unroll
    for (int i = 0; i < 8; ++i) v[i] = *(const f32x4*)(src + (size_t)(k0 + r0 + 16 * i) * N);
    LAS bf16* T = (LAS bf16*)lds;
#pragma unroll
    for (int i = 0; i < 8; ++i) { const int r = r0 + 16 * i; const float g = gk ? sc * gk[k0 + r] : sc;
#pragma unroll
        for (int e = 0; e < 4; ++e) T[(4 * p4 + e) * 136 + r] = (bf16)f2bf(v[i][e] * g); }
    __syncthreads();
#pragma unroll
    for (int j = 0; j < 4; ++j) { const int c = tid + 512 * j, row = c >> 4, ch = c & 15;
        *(GAS v4u*)(WT + (size_t)(n0 + row) * ldt + koff + k0 + 8 * ch) = *(const LAS v4u*)(lds + row * 272 + ch * 16); }
    __syncthreads();
}
__device__ __forceinline__ void rms_row_to_bf16(const float* xrow, const float* gain, bf16* orow, int lane) {
    const GAS f32x4* xr = (const GAS f32x4*)xrow + lane; const GAS f32x4* gr = (const GAS f32x4*)gain + lane;
    f32x4 v[4]; float s = 0.f;
#pragma unroll
    for (int j = 0; j < 4; ++j) { v[j] = xr[64 * j]; s += (v[j].x * v[j].x + v[j].y * v[j].y) + (v[j].z * v[j].z + v[j].w * v[j].w); }
    const float rstd = 1.f / sqrtf(wave_sum(s) * (1.f / DM) + EPS);
    GAS unsigned long long* o8 = (GAS unsigned long long*)orow + lane;
#pragma unroll
    for (int j = 0; j < 4; ++j) { const f32x4 g = gr[64 * j]; o8[64 * j] = (unsigned long long)pk2(v[j].x * rstd * g.x, v[j].y * rstd * g.y) | ((unsigned long long)pk2(v[j].z * rstd * g.z, v[j].w * rstd * g.w) << 32); }
}
__device__ __forceinline__ void rms_rows4_to_bf16(const float* xbase, const float* gain, bf16* obase, int m0, int stride, int lane) {
    f32x4 v[4][4]; float s[4];
#pragma unroll
    for (int q = 0; q < 4; ++q) { const GAS f32x4* xr = (const GAS f32x4*)(xbase + (size_t)(m0 + q * stride) * DM) + lane;
#pragma unroll
        for (int j = 0; j < 4; ++j) v[q][j] = xr[64 * j]; }
#pragma unroll
    for (int q = 0; q < 4; ++q) { float a = 0.f;
#pragma unroll
        for (int j = 0; j < 4; ++j) a += (v[q][j].x * v[q][j].x + v[q][j].y * v[q][j].y) + (v[q][j].z * v[q][j].z + v[q][j].w * v[q][j].w);
        s[q] = 1.f / sqrtf(wave_sum(a) * (1.f / DM) + EPS); }
    const GAS f32x4* gr = (const GAS f32x4*)gain + lane;
#pragma unroll
    for (int j = 0; j < 4; ++j) { const f32x4 g = gr[64 * j];
#pragma unroll
        for (int q = 0; q < 4; ++q) { GAS unsigned long long* o8 = (GAS unsigned long long*)(obase + (size_t)(m0 + q * stride) * DM) + lane;
            o8[64 * j] = (unsigned long long)pk2(v[q][j].x * s[q] * g.x, v[q][j].y * s[q] * g.y) | ((unsigned long long)pk2(v[q][j].z * s[q] * g.z, v[q][j].w * s[q] * g.w) << 32); } }
}
__device__ __forceinline__ void rope_cs(int pos, int f, int dh, float& c, float& s) {
    const float inv = exp2f(-((float)(2 * f) / (float)dh) * 13.287712379549449f);
    const float ang = (float)pos * inv;
    const double x = (double)ang, n = __builtin_rint(x * 0.15915494309189535);
    double r = __builtin_fma(-n, 6.283185307179586, x); r = __builtin_fma(-n, 2.4492935982947064e-16, r);
    const double r2 = r * r; double ts = r, ss = r, tc = 1.0, sc = 1.0;
#pragma unroll
    for (int k = 1; k <= 15; ++k) { tc *= r2 * (-1.0 / (double)((2 * k - 1) * (2 * k))); sc += tc; ts *= r2 * (-1.0 / (double)((2 * k) * (2 * k + 1))); ss += ts; }
    c = (float)sc; s = (float)ss;
}

typedef float f32x16 __attribute__((ext_vector_type(16)));
typedef short s16x4 __attribute__((ext_vector_type(4)));
#define MFMA32(a, b, c) __builtin_amdgcn_mfma_f32_32x32x16_bf16((a), (b), (c), 0, 0, 0)
__device__ __forceinline__ int crow(int r, int hi) { return (r & 3) + 8 * (r >> 2) + 4 * hi; }
__device__ __forceinline__ bf16x8 ld16(const bf16* p) { return *(const bf16x8*)p; }
__device__ __forceinline__ float bf2f(short b) { return __builtin_bit_cast(float, (unsigned)(unsigned short)b << 16); }
template <int BASE> __device__ __forceinline__ bf16x8 pack8(const f32x16& p) {
    v4u w; w.x = pk2(p[BASE], p[BASE + 1]); w.y = pk2(p[BASE + 2], p[BASE + 3]); w.z = pk2(p[BASE + 4], p[BASE + 5]); w.w = pk2(p[BASE + 6], p[BASE + 7]);
    return __builtin_bit_cast(bf16x8, w);
}
__device__ __forceinline__ f32x16 splat16(float v) { f32x16 r;
#pragma unroll
    for (int i = 0; i < 16; ++i) r[i] = v;
    return r; }
#define GLDS16(gptr, ldsptr) __builtin_amdgcn_global_load_lds((const unsigned*)(gptr), (LAS unsigned*)(ldsptr), 16, 0, 0)
struct SmState { float m, l; f32x16 negm; };
constexpr float SM_THR = 8.0f;
template <int NS, int NO, int KRB>
__device__ __forceinline__ void attn_half_sw(const LAS unsigned char* kl, const LAS unsigned char* vl, const bf16x8 (&qf)[NS], SmState& S, f32x16 (&o)[NO], int kbh, bool first, int r, int hh) {
    f32x16 p0;
    const int x7 = r & 7;
    const LAS unsigned char* ka = kl + (32 * kbh + r) * KRB;
#pragma unroll
    for (int s = 0; s < NS; ++s) { const int co = ((2 * s + hh) ^ x7) << 4; const bf16x8 a0 = *(const LAS bf16x8*)(ka + co);
        if (s == 0) p0 = MFMA32(a0, qf[0], S.negm); else p0 = MFMA32(a0, qf[s], p0); }
    float ta = fmaxf(fmaxf(p0[0], p0[1]), p0[2]), tb = fmaxf(fmaxf(p0[3], p0[4]), p0[5]);
    ta = fmaxf(fmaxf(ta, p0[6]), p0[7]); tb = fmaxf(fmaxf(tb, p0[8]), p0[9]); ta = fmaxf(fmaxf(ta, p0[10]), p0[11]); tb = fmaxf(fmaxf(tb, p0[12]), p0[13]); ta = fmaxf(fmaxf(ta, p0[14]), p0[15]);
    float tm = fmaxf(ta, tb);
    { const auto rr = __builtin_amdgcn_permlane32_swap(__float_as_uint(tm), __float_as_uint(tm), false, false); tm = fmaxf(__uint_as_float(rr[0]), __uint_as_float(rr[1])); }
    if (first || __any(tm > SM_THR)) {
        float dl = first ? tm : fmaxf(tm, 0.f); if (dl == NEG_INF) dl = 0.f;
        S.m += dl;
#pragma unroll
        for (int rg = 0; rg < 16; ++rg) { p0[rg] -= dl; S.negm[rg] = -S.m; }
        if (!first) { const float f = __builtin_amdgcn_exp2f(-dl); S.l *= f;
#pragma unroll
            for (int db = 0; db < NO; ++db) o[db] = o[db] * f; }
    }
    float sum = 0.f;
#pragma unroll
    for (int rg = 0; rg < 16; ++rg) { p0[rg] = __builtin_amdgcn_exp2f(p0[rg]); sum += p0[rg]; }
    S.l += sum;
    v4u w0, w1;
    w0.x = pk2(p0[0], p0[1]); w0.y = pk2(p0[2], p0[3]); w0.z = pk2(p0[4], p0[5]); w0.w = pk2(p0[6], p0[7]);
    w1.x = pk2(p0[8], p0[9]); w1.y = pk2(p0[10], p0[11]); w1.z = pk2(p0[12], p0[13]); w1.w = pk2(p0[14], p0[15]);
    const bf16x8 pb0 = __builtin_bit_cast(bf16x8, w0), pb1 = __builtin_bit_cast(bf16x8, w1);
#pragma unroll
    for (int db = 0; db < NO; ++db) { const LAS unsigned char* vr = vl + (32 * db + r) * 128 + 8 * hh;
#define VFRAG(i) ({ const s16x4 lo_ = *(const LAS s16x4*)(vr + (((2 * (i)) ^ x7) << 4)), hi_ = *(const LAS s16x4*)(vr + (((2 * (i) + 1) ^ x7) << 4)); (bf16x8){lo_[0], lo_[1], lo_[2], lo_[3], hi_[0], hi_[1], hi_[2], hi_[3]}; })
        o[db] = MFMA32(VFRAG(2 * kbh), pb0, o[db]); o[db] = MFMA32(VFRAG(2 * kbh + 1), pb1, o[db]);
#undef VFRAG
    }
}
template <int NS, int NO, int KRB, int MASK>
__device__ __forceinline__ void attn_tile_bf(const LAS unsigned char* kl, const LAS unsigned char* vl, const bf16x8 (&qf)[NS], float& m, float& l, f32x16 (&o)[NO], int qd, bool lane_on, int r, int hh) {
    f32x16 p0 = splat16(0.f), p1 = splat16(0.f);
    const int x7 = r & 7;
    const LAS unsigned char* ka = kl + r * KRB;
#pragma unroll
    for (int s = 0; s < NS; ++s) { const int co = ((2 * s + hh) ^ x7) << 4; const bf16x8 a0 = *(const LAS bf16x8*)(ka + co), a1 = *(const LAS bf16x8*)(ka + 32 * KRB + co); p0 = MFMA32(a0, qf[s], p0); p1 = MFMA32(a1, qf[s], p1); }
    if (MASK == 1) {
#pragma unroll
        for (int rg = 0; rg < 16; ++rg) { const int kv = crow(rg, hh); if (kv > qd) p0[rg] = NEG_INF; if (kv + 32 > qd) p1[rg] = NEG_INF; }
    }
    float ta = fmaxf(fmaxf(p0[0], p0[1]), p1[0]), tb = fmaxf(fmaxf(p0[2], p0[3]), p1[1]); ta = fmaxf(fmaxf(ta, p1[2]), p1[3]);
#pragma unroll
    for (int rg = 4; rg < 16; rg += 4) { ta = fmaxf(fmaxf(ta, p0[rg]), p0[rg + 1]); tb = fmaxf(fmaxf(tb, p0[rg + 2]), p0[rg + 3]); ta = fmaxf(fmaxf(ta, p1[rg]), p1[rg + 1]); tb = fmaxf(fmaxf(tb, p1[rg + 2]), p1[rg + 3]); }
    float tm = fmaxf(ta, tb);
    { const auto rr = __builtin_amdgcn_permlane32_swap(__float_as_uint(tm), __float_as_uint(tm), false, false); tm = fmaxf(__uint_as_float(rr[0]), __uint_as_float(rr[1])); }
    if (MASK == 2) tm = lane_on ? tm : NEG_INF;
    const float mn = (tm > m + SM_THR) ? tm : m, ms = (mn == NEG_INF) ? 0.f : mn;
    const float f = __builtin_amdgcn_exp2f(m - ms);
    m = mn;
    float sum = 0.f;
#pragma unroll
    for (int rg = 0; rg < 16; ++rg) { p0[rg] = __builtin_amdgcn_exp2f(p0[rg] - ms); p1[rg] = __builtin_amdgcn_exp2f(p1[rg] - ms); sum += p0[rg] + p1[rg]; }
    v4u w0, w1, w2, w3;
    w0.x = pk2(p0[0], p0[1]); w0.y = pk2(p0[2], p0[3]); w0.z = pk2(p0[4], p0[5]); w0.w = pk2(p0[6], p0[7]);
    w1.x = pk2(p0[8], p0[9]); w1.y = pk2(p0[10], p0[11]); w1.z = pk2(p0[12], p0[13]); w1.w = pk2(p0[14], p0[15]);
    w2.x = pk2(p1[0], p1[1]); w2.y = pk2(p1[2], p1[3]); w2.z = pk2(p1[4], p1[5]); w2.w = pk2(p1[6], p1[7]);
    w3.x = pk2(p1[8], p1[9]); w3.y = pk2(p1[10], p1[11]); w3.z = pk2(p1[12], p1[13]); w3.w = pk2(p1[14], p1[15]);
    if (MASK == 2) { const unsigned km = lane_on ? 0xffffffffu : 0u; w0 = w0 & km; w1 = w1 & km; w2 = w2 & km; w3 = w3 & km; sum = lane_on ? sum : 0.f; }
    l = l * f + sum;
    const bf16x8 pb0 = __builtin_bit_cast(bf16x8, w0), pb1 = __builtin_bit_cast(bf16x8, w1), pb2 = __builtin_bit_cast(bf16x8, w2), pb3 = __builtin_bit_cast(bf16x8, w3);
#pragma unroll
    for (int db = 0; db < NO; ++db) { const LAS unsigned char* vr = vl + (32 * db + r) * 128 + 8 * hh; o[db] = o[db] * f;
#define VFRAG(i) ({ const s16x4 lo_ = *(const LAS s16x4*)(vr + (((2 * (i)) ^ x7) << 4)), hi_ = *(const LAS s16x4*)(vr + (((2 * (i) + 1) ^ x7) << 4)); (bf16x8){lo_[0], lo_[1], lo_[2], lo_[3], hi_[0], hi_[1], hi_[2], hi_[3]}; })
        o[db] = MFMA32(VFRAG(0), pb0, o[db]); o[db] = MFMA32(VFRAG(1), pb1, o[db]); o[db] = MFMA32(VFRAG(2), pb2, o[db]); o[db] = MFMA32(VFRAG(3), pb3, o[db]);
#undef VFRAG
    }
}
constexpr int MD_STG = 16384;
__device__ __forceinline__ void moba_unit_dma(LAS unsigned char* lds, bf16* YAB, const bf16* AK, const bf16* AVT, const float* KMEAN, int b, int h, int qb, int w, int lane) {
    const int r = lane & 31, hh = lane >> 5, qrel = 32 * w + r;
    bf16* Qp = YAB + pg8::yab_idx((size_t)b * SEQ + qb * 256 + qrel, h * 64);
    const int srow = 8 * w + (lane >> 3), sch = (lane & 7) ^ (lane >> 3);
    const bf16* kg = AK + ((size_t)(b * 8 + h) * SEQ + srow) * 64 + sch * 8;
    const bf16* vg = AVT + ((size_t)(b * 8 + h) * 64 * 64 + srow) * 64 + sch * 8;
    LAS unsigned char* kd = lds + w * 1024;
    const int NT = 4 + 4 * qb;
#define MD_KPOS(t) (((t) < 4) ? qb * 256 + 64 * (t) : 64 * ((t) - 4))
#define MD_ISSUE(t) do { const int kp_ = MD_KPOS(t); LAS unsigned char* d_ = kd + ((t) & 3) * MD_STG; GLDS16(kg + (size_t)kp_ * 64, d_); GLDS16(vg + (size_t)(kp_ >> 6) * 4096, d_ + 8192); } while (0)
    MD_ISSUE(0); MD_ISSUE(1); MD_ISSUE(2);
    bf16x8 qf[4];
#pragma unroll
    for (int s = 0; s < 4; ++s) qf[s] = ld16(Qp + 16 * s + 8 * hh);
    LAS float* kml = (LAS float*)(lds + 4 * MD_STG);
    { const int e = 2 * (w * 64 + lane); const unsigned long long kv = *(const unsigned long long*)(KMEAN + (size_t)(b * 16 + (e >> 6)) * 512 + h * 64 + (e & 63)); *(LAS unsigned long long*)(kml + e) = kv; }
    float m_run = NEG_INF, l_run = 0.f; f32x16 o[2]; o[0] = splat16(0.f); o[1] = splat16(0.f);
    asm volatile("s_waitcnt vmcnt(0) lgkmcnt(0)" ::: "memory"); __builtin_amdgcn_s_barrier(); asm volatile("" ::: "memory");
    unsigned selmask = 0u;
    if (qb > 0) {
        const LAS float* km = kml + 8 * hh;
        float v1 = NEG_INF, v2 = NEG_INF, v3 = NEG_INF; int i1 = -1, i2 = -1, i3 = -1;
        for (int j = 0; j < qb; ++j) {
            float dot = 0.f;
#pragma unroll
            for (int s = 0; s < 4; ++s) { const f32x4 ka = *(const LAS f32x4*)(km + j * 64 + 16 * s), kb = *(const LAS f32x4*)(km + j * 64 + 16 * s + 4);
                dot += bf2f(qf[s][0]) * ka[0] + bf2f(qf[s][1]) * ka[1] + bf2f(qf[s][2]) * ka[2] + bf2f(qf[s][3]) * ka[3] + bf2f(qf[s][4]) * kb[0] + bf2f(qf[s][5]) * kb[1] + bf2f(qf[s][6]) * kb[2] + bf2f(qf[s][7]) * kb[3]; }
            dot += __shfl_xor(dot, 32);
            if (dot > v1) { v3 = v2; i3 = i2; v2 = v1; i2 = i1; v1 = dot; i1 = j; } else if (dot > v2) { v3 = v2; i3 = i2; v2 = dot; i2 = j; } else if (dot > v3) { v3 = dot; i3 = j; }
        }
        if (i1 >= 0) selmask |= 1u << i1; if (i2 >= 0) selmask |= 1u << i2; if (i3 >= 0) selmask |= 1u << i3;
    }
#define MD_END(t) do { if ((t) + 3 < NT) asm volatile("s_waitcnt vmcnt(4) lgkmcnt(0)" ::: "memory"); else asm volatile("s_waitcnt vmcnt(0) lgkmcnt(0)" ::: "memory"); \
        __builtin_amdgcn_s_barrier(); asm volatile("" ::: "memory"); } while (0)
    for (int t = 0; t < 4; ++t) {
        const LAS unsigned char* sb = lds + (t & 3) * MD_STG;
        if (t + 3 < NT) MD_ISSUE(t + 3);
        if (t <= (w >> 1)) attn_tile_bf<4, 2, 128, 1>(sb, sb + 8192, qf, m_run, l_run, o, qrel - 64 * t, true, r, hh);
        MD_END(t);
    }
    for (int t = 4; t < NT; ++t) {
        const LAS unsigned char* sb = lds + (t & 3) * MD_STG;
        if (t + 3 < NT) MD_ISSUE(t + 3);
        const bool on = (selmask >> ((t - 4) >> 2)) & 1u;
        attn_tile_bf<4, 2, 128, 2>(sb, sb + 8192, qf, m_run, l_run, o, 0, on, r, hh);
        MD_END(t);
    }
#undef MD_END
#undef MD_ISSUE
#undef MD_KPOS
    const float inv = 1.0f / (l_run + __shfl_xor(l_run, 32));
#pragma unroll
    for (int db = 0; db < 2; ++db)
#pragma unroll
        for (int g = 0; g < 4; ++g) {
            const unsigned lo = pk2(o[db][4 * g] * inv, o[db][4 * g + 1] * inv), hi = pk2(o[db][4 * g + 2] * inv, o[db][4 * g + 3] * inv);
            *(unsigned long long*)(Qp + 32 * db + 8 * g + 4 * hh) = (unsigned long long)lo | ((unsigned long long)hi << 32); }
    asm volatile("s_waitcnt vmcnt(0)" ::: "memory");
}

constexpr int XA_STG = 65536;
__device__ __forceinline__ void xattn_units(LAS unsigned char* lds, const bf16* QX, const bf16* KX, const bf16* VXT, bf16* OX, int u0, int nu, int w, int lane) {
    const int r = lane & 31, hh = lane >> 5, qg = w >> 1, dh = w & 1;
    const int kr0 = 8 * w + (lane >> 5), vr0 = 32 * w + (lane >> 3);
    LAS unsigned char* dk = lds + w * 4096; LAS unsigned char* dv = lds + 32768 + w * 4096;
#define XA_ISSUE(T) do { const int u_ = u0 + ((T) >> 2), kt_ = (T) & 3, bh_ = u_ >> 5; const int sg_ = ((T) & 1) * XA_STG; \
        const bf16* kb_ = KX + ((size_t)(bh_ * 256 + 64 * kt_)) * 256; const bf16* vb_ = VXT + ((size_t)(bh_ * 4 + kt_) * 256) * 64; \
        _Pragma("unroll") for (int i_ = 0; i_ < 4; ++i_) { const int row_ = kr0 + 2 * i_; GLDS16(kb_ + (size_t)row_ * 256 + (((lane & 31) ^ (row_ & 7)) << 3), dk + sg_ + i_ * 1024); } \
        _Pragma("unroll") for (int i_ = 0; i_ < 4; ++i_) { const int row_ = vr0 + 8 * i_; GLDS16(vb_ + (size_t)row_ * 64 + (((lane & 7) ^ (lane >> 3)) << 3), dv + sg_ + i_ * 1024); } } while (0)
    const int NTT = 4 * nu;
    XA_ISSUE(0);
    bf16x8 qf[16]; SmState S; f32x16 o[4];
    for (int T = 0; T < NTT; ++T) {
        const int t = T & 3, u = u0 + (T >> 2), bh = u >> 5;
        const size_t qrow = (size_t)(bh >> 2) * SEQ + (u & 31) * 128 + 32 * qg + r;
        if (t == 0) {
#pragma unroll
            for (int s = 0; s < 16; ++s) qf[s] = ld16(QX + qrow * 1024 + (bh & 3) * 256 + 16 * s + 8 * hh);
            S.m = 0.f; S.l = 0.f; S.negm = splat16(0.f);
#pragma unroll
            for (int db = 0; db < 4; ++db) o[db] = splat16(0.f);
        }
        asm volatile("s_waitcnt vmcnt(0) lgkmcnt(0)" ::: "memory"); __builtin_amdgcn_s_barrier(); asm volatile("" ::: "memory");
        if (T + 1 < NTT) XA_ISSUE(T + 1);
        const LAS unsigned char* sb = lds + (T & 1) * XA_STG;
        attn_half_sw<16, 4, 512>(sb, sb + 32768 + dh * 16384, qf, S, o, 0, t == 0, r, hh);
        attn_half_sw<16, 4, 512>(sb, sb + 32768 + dh * 16384, qf, S, o, 1, false, r, hh);
        if (t == 3) {
            const float inv = 1.0f / (S.l + __shfl_xor(S.l, 32));
            bf16* op = OX + qrow * 1024 + (bh & 3) * 256 + 128 * dh + 4 * hh;
#pragma unroll
            for (int db = 0; db < 4; ++db)
#pragma unroll
                for (int g = 0; g < 4; ++g) { const unsigned lo = pk2(o[db][4 * g] * inv, o[db][4 * g + 1] * inv), hi = pk2(o[db][4 * g + 2] * inv, o[db][4 * g + 3] * inv);
                    *(unsigned long long*)(op + 32 * db + 8 * g) = (unsigned long long)lo | ((unsigned long long)hi << 32); }
        }
    }
#undef XA_ISSUE
    asm volatile("s_waitcnt vmcnt(0) lgkmcnt(0)" ::: "memory"); __builtin_amdgcn_s_barrier(); asm volatile("" ::: "memory");
}

constexpr int SC_STG = 32768;
__device__ __forceinline__ void scan_unit(LAS unsigned char* lds, const bf16* RKT, const bf16* RVT, bf16* ST, int b, int hr, int es, int lane) {
    const int r = lane & 31, hh = lane >> 5; const float dec = __builtin_amdgcn_exp2f(128.0f * pg8::lg2gamma(hr));
    const int dl = 16 * ((r >> 2) & 1) + (r & 3) + 4 * (r >> 3), kkey = (dl & 7) + 8 * ((dl >> 4) & 1);
    f32x16 st[4];
#pragma unroll
    for (int db = 0; db < 4; ++db) st[db] = splat16(0.f);
    const int krow = 16 * es + (lane >> 4);
    const bf16* kg0 = RKT + ((size_t)(b * 4 + hr) * NCHUNK * 128 + krow) * 128;
    const int kx4 = ((lane & 15) ^ ((lane >> 4) + 8 * (es & 1))) << 3, kx4b = ((lane & 15) ^ ((lane >> 4) + 4 + 8 * (es & 1))) << 3;
    LAS unsigned char* kd = lds + es * 4096;
    const bf16* vt = RVT + ((size_t)(b * 4 + hr) * NCHUNK * 256 + 32 * es + r) * 128 + 8 * hh;
    bf16* sto = ST + ((size_t)((b * 4 + hr) * NCHUNK)) * 32768 + ((es * 16 + 2 * hh) * 32 + r) * 8;
    bf16x8 vX[8], vY[8];
#define SC_DMA(c, stg) do { _Pragma("unroll") for (int i = 0; i < 4; ++i) GLDS16(kg0 + (size_t)(c) * 16384 + i * 512 + ((i & 1) ? kx4b : kx4), kd + ((stg) & 3) * SC_STG + i * 1024); } while (0)
#define SC_VLD(dst, c, s_) do { const bf16* p_ = vt + (size_t)(c) * 32768 + 16 * (s_); asm volatile("global_load_dwordx4 %0, %1, off" : "=v"(dst) : "v"(p_) : "memory"); } while (0)
#define SC_VWAIT(V_, N) asm volatile("s_waitcnt vmcnt(" #N ")" : "+v"(V_[0]), "+v"(V_[1]), "+v"(V_[2]), "+v"(V_[3]), "+v"(V_[4]), "+v"(V_[5]), "+v"(V_[6]), "+v"(V_[7]) :: "memory")
    SC_DMA(0, 0);
#pragma unroll
    for (int s_ = 0; s_ < 8; ++s_) SC_VLD(vX[s_], 0, s_);
    SC_DMA(1, 1);
#pragma unroll
    for (int s_ = 0; s_ < 8; ++s_) SC_VLD(vY[s_], 1, s_);
    SC_VWAIT(vX, 0); SC_VWAIT(vY, 0);
    __builtin_amdgcn_s_barrier(); asm volatile("" ::: "memory");
#define SC_STEP(n_, Vc) { \
        _Pragma("unroll") for (int db = 0; db < 4; ++db) { *(bf16x8*)(sto + (size_t)(n_) * 32768 + (4 * db) * 256) = pack8<0>(st[db]); *(bf16x8*)(sto + (size_t)(n_) * 32768 + (4 * db + 1) * 256) = pack8<8>(st[db]); } \
        if ((n_) == NCHUNK - 1) break; \
        const int c2_ = ((n_) + 2 < NCHUNK - 1) ? (n_) + 2 : NCHUNK - 2;     \
        asm volatile("" ::: "memory"); \
        SC_DMA(c2_, (n_) + 2); \
        SC_VWAIT(Vc, 32);                                                  \
        const LAS unsigned char* ka = lds + ((n_) & 3) * SC_STG + dl * 256; \
        _Pragma("unroll") for (int db = 0; db < 4; ++db) st[db] = st[db] * dec; \
        _Pragma("unroll") for (int s_ = 0; s_ < 8; ++s_) { \
            _Pragma("unroll") for (int db = 0; db < 4; ++db) st[db] = MFMA32(*(const LAS bf16x8*)(ka + db * 8192 + (((2 * s_ + hh) ^ kkey) << 4)), Vc[s_], st[db]); \
            SC_VLD(Vc[s_], c2_, s_); } \
          \
        asm volatile("s_waitcnt vmcnt(28) lgkmcnt(0)" ::: "memory"); \
        __builtin_amdgcn_s_barrier(); asm volatile("" ::: "memory"); }
    for (int n = 0; ; n += 2) {
        SC_STEP(n, vX)
        SC_STEP(n + 1, vY)
    }
#undef SC_STEP
#undef SC_VWAIT
#undef SC_VLD
#undef SC_DMA
    asm volatile("s_waitcnt vmcnt(0) lgkmcnt(0)" ::: "memory"); __builtin_amdgcn_s_barrier(); asm volatile("" ::: "memory");
}

constexpr int RC_SLOT = 32768;
__device__ __forceinline__ void retc_units(LAS unsigned char* lds, LAS float* xch, const bf16* RQ, const bf16* RK, const bf16* RVT, const bf16* ST, const bf16* RG, bf16* YAB, int u0, int nu, int w, int lane) {
    const int r = lane & 31, hh = lane >> 5, ib = w >> 1, eh = w & 1, x7 = r & 7, il = 32 * ib + r;
    const int prow = 16 * w + (lane >> 4);
    const int NG = 5 * nu;
#define RC_ISSUE(UI, K) do { const int u_ = u0 + (UI), bh_ = u_ >> 5, n_ = u_ & 31; LAS unsigned char* d_ = lds + ((5 * (UI) + (K)) & 3) * RC_SLOT + w * 4096; \
        _Pragma("unroll") for (int i_ = 0; i_ < 4; ++i_) { const int row_ = prow + 4 * i_; const int co_ = (((lane & 15) ^ (row_ & 7)) << 3); const bf16* src_; \
            if ((K) == 0) src_ = RK + ((size_t)bh_ * SEQ + n_ * 128 + row_) * 128 + co_; \
            else if ((K) & 1) { const int p_ = 4 * w + i_, e_ = 64 * ((K) - 1) + 64 * (p_ & 1) + lane; src_ = ST + (size_t)(bh_ * NCHUNK + n_) * 32768 + (((e_ >> 5) * 16 + (p_ >> 1)) * 32 + (e_ & 31)) * 8; }     \
            else src_ = RVT + ((size_t)(bh_ * NCHUNK + n_) * 256 + 64 * ((K) - 2) + row_) * 128 + co_; \
            GLDS16(src_, d_ + i_ * 1024); } } while (0)
#define RC_STEP(UI, K) do { const int g_ = 5 * (UI) + (K); \
        if (g_ + 2 < NG) asm volatile("s_waitcnt vmcnt(8) lgkmcnt(0)" ::: "memory"); else if (g_ + 1 < NG) asm volatile("s_waitcnt vmcnt(4) lgkmcnt(0)" ::: "memory"); else asm volatile("s_waitcnt vmcnt(0) lgkmcnt(0)" ::: "memory"); \
        __builtin_amdgcn_s_barrier(); asm volatile("" ::: "memory"); \
        if (g_ + 3 < NG) { if ((K) < 2) RC_ISSUE((UI), (K) + 3); else RC_ISSUE((UI) + 1, (K) - 2); } } while (0)
#define RC_SB(UI, K) (lds + ((5 * (UI) + (K)) & 3) * RC_SLOT)
#define RC_CROSS(SB, A0) do { _Pragma("unroll") for (int e2 = 0; e2 < 2; ++e2) { f32x16 c_ = splat16(0.f); const LAS unsigned char* sa_ = (SB) + (64 * eh + 32 * e2 + r) * 16 + hh * 2048; \
            _Pragma("unroll") for (int s = 0; s < 8; ++s) c_ = MFMA32(*(const LAS bf16x8*)(sa_ + s * 4096), qf[s], c_); \
            acc[(A0) + e2] = c_ * qd; } } while (0)
#define RC_INNER(SB, A0) do { _Pragma("unroll") for (int e2 = 0; e2 < 2; ++e2) { const LAS unsigned char* va_ = (SB) + (64 * eh + 32 * e2 + r) * 256 + 8 * hh; \
            _Pragma("unroll") for (int jb = 0; jb < 4; ++jb) if (jb <= ib) { \
                _Pragma("unroll") for (int s2 = 0; s2 < 2; ++s2) { const int ch_ = 4 * jb + 2 * s2; \
                    const s16x4 lo_ = *(const LAS s16x4*)(va_ + ((ch_ ^ x7) << 4)), hi_ = *(const LAS s16x4*)(va_ + (((ch_ + 1) ^ x7) << 4)); \
                    acc[(A0) + e2] = MFMA32(((bf16x8){lo_[0], lo_[1], lo_[2], lo_[3], hi_[0], hi_[1], hi_[2], hi_[3]}), pb[jb][s2], acc[(A0) + e2]); } } } } while (0)
    RC_ISSUE(0, 0); RC_ISSUE(0, 1); RC_ISSUE(0, 2);
    for (int ui = 0; ui < nu; ++ui) {
        const int u = u0 + ui, bh = u >> 5, n = u & 31, hr = bh & 3;
        const float lg = pg8::lg2gamma(hr), qd = __builtin_amdgcn_exp2f((float)(il + 1) * lg);
        const size_t trow = (size_t)(bh >> 2) * SEQ + n * 128 + il;
        bf16x8 qf[8]; bf16x8 pb[4][2]; f32x16 acc[4];
#pragma unroll
        for (int s = 0; s < 8; ++s) qf[s] = ld16(RQ + ((size_t)bh * SEQ + n * 128 + il) * 128 + 16 * s + 8 * hh);
        RC_STEP(ui, 0);
#pragma unroll
        for (int jb = 0; jb < 4; ++jb) if (jb <= ib) {
            f32x16 sT = splat16(0.f);
            const LAS unsigned char* ka = RC_SB(ui, 0) + (32 * jb + r) * 256;
#pragma unroll
            for (int s = 0; s < 8; ++s) sT = MFMA32(*(const LAS bf16x8*)(ka + (((2 * s + hh) ^ x7) << 4)), qf[s], sT);
            int ilo = il; asm volatile("" : "+v"(ilo));
#pragma unroll
            for (int rg = 0; rg < 16; ++rg) { const int diff = ilo - (32 * jb + crow(rg, hh)); sT[rg] = diff >= 0 ? sT[rg] * __builtin_amdgcn_exp2f((float)diff * lg) : 0.f; }
            pb[jb][0] = pack8<0>(sT); pb[jb][1] = pack8<8>(sT);
        } else { pb[jb][0] = pb[jb][1] = (bf16x8){0, 0, 0, 0, 0, 0, 0, 0}; }
        RC_STEP(ui, 1); RC_CROSS(RC_SB(ui, 1), 0);
        RC_STEP(ui, 2); RC_INNER(RC_SB(ui, 2), 0);
        RC_STEP(ui, 3); RC_CROSS(RC_SB(ui, 3), 2);
        RC_STEP(ui, 4); RC_INNER(RC_SB(ui, 4), 2);
        float s1 = 0.f, s2 = 0.f;
#pragma unroll
        for (int a = 0; a < 4; ++a)
#pragma unroll
            for (int rg = 0; rg < 16; ++rg) { s1 += acc[a][rg]; s2 += acc[a][rg] * acc[a][rg]; }
        s1 += __shfl_xor(s1, 32); s2 += __shfl_xor(s2, 32);
        if (hh == 0) { xch[(w * 32 + r) * 2] = s1; xch[(w * 32 + r) * 2 + 1] = s2; }
        asm volatile("s_waitcnt lgkmcnt(0)" ::: "memory"); __builtin_amdgcn_s_barrier(); asm volatile("" ::: "memory");
        s1 += xch[((w ^ 1) * 32 + r) * 2]; s2 += xch[((w ^ 1) * 32 + r) * 2 + 1];
        const float mean = s1 * (1.0f / 256.0f), var = fmaxf(s2 * (1.0f / 256.0f) - mean * mean, 0.f), rstd = 1.0f / sqrtf(var + EPS);
        const bf16* rgp = RG + trow * 1024 + hr * 256 + 64 * eh + 4 * hh; bf16* yo = YAB + pg8::yab_idx(trow, 512 + hr * 256 + 64 * eh) + 4 * hh;
#pragma unroll
        for (int a = 0; a < 4; ++a)
#pragma unroll
            for (int g = 0; g < 4; ++g) { const int eo = 128 * (a >> 1) + 32 * (a & 1) + 8 * g; const f32x4 gt = pg8::unpk4(*(const pg8::u32x2*)(rgp + eo)); f32x4 y;
#pragma unroll
                for (int i = 0; i < 4; ++i) y[i] = (acc[a][4 * g + i] - mean) * rstd * gt[i];
                *(pg8::u32x2*)(yo + (a >> 1) * 2 * 16384 + 32 * (a & 1) + 8 * g) = pg8::pk4(y); }
    }
#undef RC_ISSUE
#undef RC_STEP
#undef RC_SB
#undef RC_CROSS
#undef RC_INNER
    asm volatile("s_waitcnt vmcnt(0) lgkmcnt(0)" ::: "memory"); __builtin_amdgcn_s_barrier(); asm volatile("" ::: "memory");
}

struct Args { const float* in[17]; float* out; unsigned char* ws; };
__global__ void __launch_bounds__(NWAVES * 64, 2) fwd_megakernel(Args args) {
    extern __shared__ __attribute__((aligned(16))) unsigned char lds[];
    LAS unsigned char* ldsp = (LAS unsigned char*)lds;
    const int wave = __builtin_amdgcn_readfirstlane((int)threadIdx.x >> 6);
    const int G = gridDim.x, bx = blockIdx.x, vcu = (G % 8 == 0) ? (bx % 8) * (G / 8) + bx / 8 : bx;
    const int gw = vcu * NWAVES + wave, NGW = G * NWAVES;
    unsigned char* ws = args.ws;
    gu32* ctl = (gu32*)(ws + WS_CTL);
    const float *x = args.in[0], *mem = args.in[1], *norm_mix = args.in[2], *w_in = args.in[3], *w_a = args.in[4], *w_b = args.in[5], *w_out = args.in[6], *norm_cross = args.in[7], *norm_mem = args.in[8],
                *w_xq = args.in[9], *w_xkv = args.in[10], *w_xo = args.in[11], *norm_ffn = args.in[12], *w_gate = args.in[13], *w_up = args.in[14], *w_down = args.in[15], *norm_final = args.in[16];
    float* out = args.out;
    bf16 *WIN = (bf16*)(ws + WS_WIN), *WAB = (bf16*)(ws + WS_WAB), *WOUT = (bf16*)(ws + WS_WOUT), *WXQ = (bf16*)(ws + WS_WXQ), *WXKV = (bf16*)(ws + WS_WXKV), *WXO = (bf16*)(ws + WS_WXO), *WGU = (bf16*)(ws + WS_WGU), *WDN = (bf16*)(ws + WS_WDN);
    bf16 *H = (bf16*)(ws + WS_H), *YAB = (bf16*)(ws + WS_YAB), *AK = (bf16*)(ws + WS_AK), *AVT = (bf16*)(ws + WS_AVT), *RQ = (bf16*)(ws + WS_RQ), *RK = (bf16*)(ws + WS_RK), *RKT = (bf16*)(ws + WS_RKT), *RVT = (bf16*)(ws + WS_RVT), *RG = (bf16*)(ws + WS_RG);
    bf16 *GR = (bf16*)out, *GS = (bf16*)out + (size_t)MTOK * DM;
    bf16 *ST = (bf16*)(ws + WS_ST), *QX = (bf16*)(ws + WS_QX), *MERGED = (bf16*)(ws + WS_MERGED), *OX = (bf16*)(ws + WS_OX), *XB = (bf16*)(ws + WS_XB), *ACT = (bf16*)(ws + WS_ACT);
    bf16 *MEMN = (bf16*)(ws + WS_MEMN), *KX = (bf16*)(ws + WS_KX), *VXT = (bf16*)(ws + WS_VXT);
    float *X1 = (float*)(ws + WS_X1), *SSQ1 = (float*)(ws + WS_SSQ1), *SSQ2 = (float*)(ws + WS_SSQ2), *SSQ3 = (float*)(ws + WS_SSQ3), *KMEAN = (float*)(ws + WS_KMEAN), *T64 = (float*)(ws + WS_T64), *T128 = (float*)(ws + WS_T128);

    for (int u = threadIdx.x; u < (LDS_BYTES - LDSCTL_OFF) / 4; u += NWAVES * 64) ((LAS unsigned*)(ldsp + LDSCTL_OFF))[u] = 0u;
    __syncthreads();
    XcdBarrier bar = xcd_barrier_post((unsigned*)(ctl + CW_BAR), (volatile LAS unsigned*)(ldsp + MISC_OFF) + 8);
#define GRID_BAR() xcd_barrier(bar, wave == 0 && lane_id_v() == 0)
    unsigned long long t_prev = 0ull, t_span = 0ull;
    if (PROBE_PHASE >= 0) t_prev = rt();
#define STAMP(k) do { if (PROBE_PHASE >= 0) { const unsigned long long t_ = rt(); if ((k) == PROBE_PHASE) t_span = t_ - t_prev; t_prev = t_; } } while (0)

    {
        const int lane = lane_id_v();
        constexpr int I_IN = 8 * (INC / 128), I_A = 4 * 8, I_B = 8 * 8, I_SQ = 8 * 8, I_KV = 8 * 16, I_GU = 8 * (2 * DFF / 128), I_DN = (DFF / 128) * 8;
        constexpr int NITEMS = I_IN + I_A + I_B + 3 * I_SQ + I_KV + I_GU + I_DN;
        const int tid = wave * 64 + lane;
        for (int it = vcu; it < NITEMS; it += G) {
            int q = it;
            if (q < I_IN) { p0_tile128(w_in, w_in, INC, INC, 1, WIN, 1024, 0, ldsp, q, tid); continue; } q -= I_IN;
            if (q < I_A) { p0_tile128(w_a, w_a, 1024, 1024, 0, WAB, 1536, 0, ldsp, q, tid); continue; } q -= I_A;
            if (q < I_B) { p0_tile128(w_b, w_b, 1024, 1024, 0, WAB, 1536, 512, ldsp, q, tid); continue; } q -= I_B;
            if (q < I_SQ) { p0_tile128(w_out, w_out, 1024, 1024, 0, WOUT, 1024, 0, ldsp, q, tid); continue; } q -= I_SQ;
            if (q < I_SQ) { p0_tile128(w_xq, w_xq, 1024, 1024, 0, WXQ, 1024, 0, ldsp, q, tid, norm_cross); continue; } q -= I_SQ;
            if (q < I_SQ) { p0_tile128(w_xo, w_xo, 1024, 1024, 0, WXO, 1024, 0, ldsp, q, tid); continue; } q -= I_SQ;
            if (q < I_KV) { p0_tile128(w_xkv, w_xkv, 2048, 2048, 0, WXKV, 1024, 0, ldsp, q, tid); continue; } q -= I_KV;
            if (q < I_GU) { p0_tile128(w_gate, w_up, DFF, 2 * DFF, 2, WGU, 1024, 0, ldsp, q, tid, norm_ffn); continue; } q -= I_GU;
            p0_tile128(w_down, w_down, 1024, 1024, 0, WDN, DFF, 0, ldsp, q, tid);
        }
        for (int m = gw; m < MTOK; m += 4 * NGW) { if (m + 3 * NGW < MTOK) rms_rows4_to_bf16(x, norm_mix, H, m, NGW, lane); else for (int q = m; q < MTOK; q += NGW) rms_row_to_bf16(x + (size_t)q * DM, norm_mix, H + (size_t)q * DM, lane); }
        for (int m = gw; m < MMEM; m += NGW) rms_row_to_bf16(mem + (size_t)m * DM, norm_mem, MEMN + (size_t)m * DM, lane);
        for (int e = gw * 64 + lane; e < SEQ * 96; e += NGW * 64) {
            float c, s;
            if (e < SEQ * 32) { rope_cs(e >> 5, e & 31, 64, c, s); T64[2 * e] = c; T64[2 * e + 1] = s; }
            else { const int e2 = e - SEQ * 32; rope_cs(e2 >> 6, e2 & 63, 128, c, s); T128[2 * e2] = c; T128[2 * e2 + 1] = s; }
        }
    }
    GRID_BAR(); STAMP(0);

    {
        pg8::Gemm g{H, WIN, MTOK, INC, DM}; pg8::StaticOrderMap<0> S; S.base.init(MTOK, INC - 6 * 256, G, bx);
        pg8::EpiProj E{YAB, AK, AVT, RQ, RK, RKT, RVT, RG, GR, GS, KMEAN, T64, T128};
        pg8::gemm_phase<pg8::EpiProj, pg8::StaticOrderMap<0>, true, true>(ldsp + RING_OFF, g, S, E, wave);
        pg8::Gemm gv{WIN, H, INC, MTOK, DM}; pg8::StaticOrderMap<1> SV; SV.base.init(6 * 256, MTOK, G, bx);
        pg8::EpiVT EV{AVT, RVT};
        pg8::gemm_phase<pg8::EpiVT, pg8::StaticOrderMap<1>, true, true>(ldsp + RING_OFF, gv, SV, EV, wave);
    }
    GRID_BAR(); STAMP(1);

    {
        volatile LAS unsigned* qw = (volatile LAS unsigned*)(ldsp + LDSCTL_OFF + 64);
        constexpr unsigned NSCAN = BATCH * 4, NKVX = 64, NMOBA = BATCH * 8 * 16;
        for (;;) {
            if (wave == 0 && lane_id_v() == 0) *qw = __hip_atomic_fetch_add(ctl + CW_Q, 1u, RLX_AGENT);
            __syncthreads();
            const unsigned idx = (unsigned)__builtin_amdgcn_readfirstlane((int)*qw);
            __syncthreads();
            if (idx >= NSCAN + NKVX + NMOBA) break;
            const int ln = lane_id_v();
            if (idx < NSCAN) { scan_unit(ldsp, RKT, RVT, ST, (int)(idx >> 2), (int)(idx & 3), wave, ln); }
            else if (idx < NSCAN + NKVX) { const int k = (int)(idx - NSCAN);
                pg8::Gemm g2{MEMN, WXKV, MMEM, 2048, DM}; pg8::OneUnit S2{k >> 3, k & 7}; pg8::EpiKVX E2{KX, VXT};
                pg8::gemm_phase<pg8::EpiKVX, pg8::OneUnit, true, true>(ldsp + RING_OFF, g2, S2, E2, wave); }
            else { const unsigned k = idx - NSCAN - NKVX; const int qb = 15 - (int)(k >> 6), rem = (int)(k & 63);
                moba_unit_dma(ldsp, YAB, AK, AVT, KMEAN, rem >> 3, rem & 7, qb, wave, ln); }
        }
    }
    GRID_BAR(); STAMP(2);

    { const int per = (BATCH * 4 * NCHUNK) / G, ln = lane_id_v(); retc_units(ldsp, (LAS float*)(ldsp + LDSCTL_OFF + 1024), RQ, RK, RVT, ST, RG, YAB, vcu * per, per, wave, ln); }
    GRID_BAR(); STAMP(3);

    {
        pg8::Gemm g{YAB, WAB, MTOK, DM, 1536, 1}; pg8::StaticOrder S; S.init(MTOK, DM, G, bx);
        pg8::EpiMerge E{GR, GS, MERGED};
        pg8::gemm_phase<pg8::EpiMerge, pg8::StaticOrder, true, true>(ldsp + RING_OFF, g, S, E, wave);
    }
    GRID_BAR(); STAMP(4);

    {
        pg8::Gemm g{MERGED, WOUT, MTOK, DM, DM}; pg8::StaticOrder S; S.init(MTOK, DM, G, bx);
        pg8::EpiResid<false, true> E{x, XB, SSQ1};
        pg8::gemm_phase<pg8::EpiResid<false, true>, pg8::StaticOrder, true, true>(ldsp + RING_OFF, g, S, E, wave);
    }
    GRID_BAR(); STAMP(5);

    {
        pg8::Gemm g{XB, WXQ, MTOK, DM, DM}; pg8::StaticOrder S; S.init(MTOK, DM, G, bx);
        pg8::EpiRowScale E{SSQ1, QX, 0.0625f * LOG2E};
        pg8::gemm_phase<pg8::EpiRowScale, pg8::StaticOrder, true, true>(ldsp + RING_OFF, g, S, E, wave);
    }
    GRID_BAR(); STAMP(6);

    { const int per = (BATCH * 4 * 32) / G, ln = lane_id_v(); xattn_units(ldsp, QX, KX, VXT, OX, vcu * per, per, wave, ln); }
    GRID_BAR(); STAMP(7);

    {
        pg8::Gemm g{OX, WXO, MTOK, DM, DM}; pg8::StaticOrder S; S.init(MTOK, DM, G, bx);
        pg8::EpiResid<true, true> E{XB, XB, SSQ2};
        pg8::gemm_phase<pg8::EpiResid<true, true>, pg8::StaticOrder, true, true>(ldsp + RING_OFF, g, S, E, wave);
    }
    GRID_BAR(); STAMP(8);

    {
        pg8::Gemm g{XB, WGU, MTOK, 2 * DFF, DM}; pg8::StaticOrder S; S.init(MTOK, 2 * DFF, G, bx);
        pg8::EpiSwiGLU E{SSQ2, ACT};
        pg8::gemm_phase<pg8::EpiSwiGLU, pg8::StaticOrder, true, true>(ldsp + RING_OFF, g, S, E, wave);
    }
    GRID_BAR(); STAMP(9);

    {
        pg8::Gemm g{ACT, WDN, MTOK, DM, DFF}; pg8::StaticOrder S; S.init(MTOK, DM, G, bx);
        pg8::EpiResid<true, true> E{XB, XB, SSQ3};
        pg8::gemm_phase<pg8::EpiResid<true, true>, pg8::StaticOrder, true, true>(ldsp + RING_OFF, g, S, E, wave);
    }
    GRID_BAR(); STAMP(10);

    {
        const unsigned bad = (__hip_atomic_load(ctl + CW_TMO, RLX_AGENT) != 0u) | (__hip_atomic_load(ctl + CW_BAR + XB_TMO, RLX_AGENT) != 0u);
        const int lane = lane_id_v();
        for (int m = gw; m < MTOK; m += NGW) {
            const float rs = pg8::row_rstd(SSQ3, m);
            const GAS unsigned long long* xr = (const GAS unsigned long long*)(XB + (size_t)m * DM) + lane; GAS f32x4* orow = (GAS f32x4*)(out + (size_t)m * DM) + lane; const GAS f32x4* gr = (const GAS f32x4*)norm_final + lane;
#pragma unroll
            for (int j = 0; j < 4; ++j) { const unsigned long long w = xr[64 * j]; const unsigned lo = (unsigned)w, hi = (unsigned)(w >> 32);
                f32x4 v = (f32x4){pg8::bflo(lo), pg8::bfhi(lo), pg8::bflo(hi), pg8::bfhi(hi)} * rs * gr[64 * j];
                if (bad) v = (f32x4){__builtin_nanf(""), __builtin_nanf(""), __builtin_nanf(""), __builtin_nanf("")}; orow[64 * j] = v; }
        }
    }
    if (PROBE_PHASE >= 0) { STAMP(11); if (bx == 0 && wave == 0 && lane_id_v() == 0) { const unsigned long long t0_ = rt(); while (rt() - t0_ < t_span) __builtin_amdgcn_s_sleep(8); } }
}

extern "C" void kernel_launch(void* const* d_in, const int* in_sizes, int n_in, void* d_out, int out_size, void* d_ws, size_t ws_size, hipStream_t stream) {
    static int grid = 0;
    if (grid == 0) {
        if (n_in != 17 || in_sizes[0] != MTOK * DM || out_size != MTOK * DM || ws_size < WS_END) { fprintf(stderr, "kernel_launch: unexpected shapes (n_in %d, in0 %d, out %d, ws %zu); nothing launched\n", n_in, n_in > 0 ? in_sizes[0] : -1, out_size, ws_size); grid = -1; return; }
        int dev = 0, cus = 0, per_cu = 0;
        if (hipGetDevice(&dev) != hipSuccess || hipDeviceGetAttribute(&cus, hipDeviceAttributeMultiprocessorCount, dev) != hipSuccess) { grid = -1; return; }
        if (hipFuncSetAttribute((const void*)fwd_megakernel, hipFuncAttributeMaxDynamicSharedMemorySize, LDS_BYTES) != hipSuccess) { fprintf(stderr, "kernel_launch: hipFuncSetAttribute failed\n"); grid = -1; return; }
        if (hipOccupancyMaxActiveBlocksPerMultiprocessor(&per_cu, (const void*)fwd_megakernel, NWAVES * 64, LDS_BYTES) != hipSuccess || per_cu < 1) { fprintf(stderr, "kernel_launch: occupancy query says %d blocks per CU; nothing launched\n", per_cu); (void)hipGetLastError(); grid = -1; return; }
        grid = cus;
    }
    if (grid < 0) return;
    if (hipMemsetAsync((char*)d_ws + WS_CTL, 0, CTL_ZERO_BYTES, stream) != hipSuccess) { fprintf(stderr, "kernel_launch: hipMemsetAsync failed\n"); return; }
    Args a{};
    for (int i = 0; i < 17; ++i) a.in[i] = (const float*)d_in[i];
    a.out = (float*)d_out; a.ws = (unsigned char*)d_ws;
    void* kargs[] = {&a};
    const hipError_t le = hipLaunchCooperativeKernel((const void*)fwd_megakernel, dim3(grid), dim3(NWAVES * 64), kargs, LDS_BYTES, stream);
    if (le != hipSuccess) fprintf(stderr, "kernel_launch: cooperative launch failed: %s (grid %d)\n", hipGetErrorName(le), grid);
}
```

```cpp
#include <hip/hip_runtime.h>
#include <cstdio>
#include <cstdint>
namespace pg8 {
#define PG8_LAS __attribute__((address_space(3)))
typedef unsigned short bf16_t;
typedef short bf16x8 __attribute__((ext_vector_type(8)));
typedef float f32x4 __attribute__((ext_vector_type(4)));
typedef unsigned u32x4 __attribute__((ext_vector_type(4)));
constexpr int BM = 256, BK = 64, HALF = 128, HTB = HALF * BK * 2  , STAGE_BYTES = 8 * HTB, NXCD = 8, WGM = 4;

__host__ __device__ __forceinline__ int lds_byte(int r, int c) { const int st = (r >> 4) * 2 + (c >> 5), rr = r & 15, cc = c & 31, ob = rr * 64 + cc * 2; return st * 1024 + (ob ^ (((ob >> 9) & 1) << 5)); }
__host__ __device__ __forceinline__ void stage_rc(int b, int& R, int& C) { const int st = b / 1024, sb = b % 1024, swz = sb ^ (((sb >> 9) & 1) << 5); R = (st >> 1) * 16 + swz / 64; C = (st & 1) * 32 + (swz % 64) / 2; }
__host__ __device__ __forceinline__ int perm32(int rho) { const int n = rho >> 4, i = rho & 15; return 8 * (i >> 2) + 4 * n + (i & 3); }

struct Unit { int pm, pn; };
struct Gemm { const bf16_t* A; const bf16_t* Bt; int M, N, K; int ablk = 0; };

struct StaticOrder {
    int nM, nN, nwg, G, c;
    __host__ __device__ void init(int M, int N, int G_, int c_) { nM = M / BM; nN = N / BM; nwg = nM * nN; G = G_; c = c_; }
    __host__ __device__ bool next(int i, Unit& u) const {
        const long L = (long)i * G + c; if (L >= nwg) return false;
        int wgid = (int)L; { const int q = nwg / NXCD, r = nwg % NXCD, xcd = wgid % NXCD, off = wgid / NXCD; wgid = (xcd < r ? xcd * (q + 1) : r * (q + 1) + (xcd - r) * q) + off; }
        const int nig = WGM * nN, gid = wgid / nig, fm = gid * WGM, gsz = (nM - fm) < WGM ? (nM - fm) : WGM;
        u.pm = fm + ((wgid % nig) % gsz); u.pn = (wgid % nig) / gsz; return true;
    }
    __device__ __forceinline__ void a_ready(const Unit&) const {}
    __device__ __forceinline__ void done(const Unit&) const {}
};


template <int MODE> struct StaticOrderMap {
    StaticOrder base;
    __device__ __forceinline__ bool next(int i, Unit& u) const { if (!base.next(i, u)) return false;
        if (MODE == 0) u.pn = u.pn < 4 ? u.pn : (u.pn < 8 ? u.pn + 2 : u.pn + 6); else u.pm = u.pm < 2 ? u.pm + 4 : u.pm + 8;
        return true; }
    __device__ __forceinline__ void a_ready(const Unit&) const {}
    __device__ __forceinline__ void done(const Unit&) const {}
};
struct OneUnit {
    int pm, pn;
    __device__ __forceinline__ bool next(int i, Unit& u) const { if (i != 0) return false; u.pm = pm; u.pn = pn; return true; }
    __device__ __forceinline__ void a_ready(const Unit&) const {}
    __device__ __forceinline__ void done(const Unit&) const {}
};
struct RowRun {
    int pm, pn, n;
    __device__ __forceinline__ bool next(int i, Unit& u) const { if (i >= n) return false; u.pm = pm + i; u.pn = pn; return true; }
    __device__ __forceinline__ void a_ready(const Unit&) const {}
    __device__ __forceinline__ void done(const Unit&) const {}
};
typedef unsigned u32x2 __attribute__((ext_vector_type(2)));
typedef float f32x2_t __attribute__((ext_vector_type(2))); typedef __bf16 bf16x2_t __attribute__((ext_vector_type(2)));
__device__ __forceinline__ unsigned pk2(float lo, float hi) { const f32x2_t v = {lo, hi}; const bf16x2_t b = __builtin_convertvector(v, bf16x2_t); return __builtin_bit_cast(unsigned, b); }
__device__ __forceinline__ unsigned f2bf(float f) { return pk2(f, 0.f) & 0xffffu; }
__device__ __forceinline__ float bflo(unsigned w) { return __builtin_bit_cast(float, w << 16); }
__device__ __forceinline__ float bfhi(unsigned w) { return __builtin_bit_cast(float, w & 0xffff0000u); }
__device__ __forceinline__ u32x2 pk4(f32x4 v) { u32x2 w; w.x = pk2(v[0], v[1]); w.y = pk2(v[2], v[3]); return w; }
__device__ __forceinline__ f32x4 unpk4(u32x2 w) { return (f32x4){bflo(w.x), bfhi(w.x), bflo(w.y), bfhi(w.y)}; }
__device__ __forceinline__ float lg2gamma(int h) { return h == 0 ? -0.04580368961312479f : (h == 1 ? -0.02272007650008353f : (h == 2 ? -0.011315313227834146f : -0.005646563141142063f)); }
__device__ __forceinline__ float sigmoidf_(float v) { return __builtin_amdgcn_rcpf(1.0f + __expf(-v)); }
constexpr int SEQ_ = 4096, DM_ = 1024;

__device__ __forceinline__ u32x4 pk8(f32x4 a, f32x4 b) { u32x4 w; w.x = pk2(a[0], a[1]); w.y = pk2(a[2], a[3]); w.z = pk2(b[0], b[1]); w.w = pk2(b[2], b[3]); return w; }
__device__ __forceinline__ f32x4 unlo(u32x4 w) { return (f32x4){bflo(w.x), bfhi(w.x), bflo(w.y), bfhi(w.y)}; }
__device__ __forceinline__ f32x4 unhi(u32x4 w) { return (f32x4){bflo(w.z), bfhi(w.z), bflo(w.w), bfhi(w.w)}; }
__device__ __forceinline__ size_t yab_idx(size_t t, int c) { return ((t >> 8) * 24 + (size_t)(c >> 6)) * 16384 + (t & 255) * 64 + (c & 63); }
struct EpiProj {
    static constexpr bool PERM = false, AFTER_DRAIN = false; static constexpr int MID_T = 0;
    bf16_t *YAB, *AK, *AVT, *RQ, *RK, *RKT, *RVT, *RG, *GR, *GS; float* KMEAN; const float* T64; const float* T128;
    __device__ __forceinline__ void mid(f32x4 (&)[2][2][4][2], const Unit&, int, int, int, int) const {}
    __device__ __forceinline__ void operator()(const f32x4 (&acc)[2][2][4][2], const Unit& u, int wr, int wc, int fr_in, int fq_in) const {
        int ll_; asm volatile("v_mbcnt_lo_u32_b32 %0, -1, 0\n\tv_mbcnt_hi_u32_b32 %0, -1, %0" : "=v"(ll_)); const int fr = ll_ & 15, fq = (ll_ >> 4) & 3; (void)fr_in; (void)fq_in;
        const int pn = u.pn, rowb = u.pm * BM + wr * 64 + fr, b = u.pm >> 4;
        if (pn < 4 || (pn >= 6 && pn < 10)) {
            const bool is64 = pn < 4; const int rt = pn & 1, kind = is64 ? (pn >> 1) : (((pn - 6) >> 1) + 2);
            const int f0 = (is64 ? 16 * (wc & 1) : 16 * wc) + 4 * fq;
            f32x4 ks[2][2];
#pragma unroll
            for (int bj = 0; bj < 2; ++bj) { ks[bj][0] = (f32x4){0.f, 0.f, 0.f, 0.f}; ks[bj][1] = (f32x4){0.f, 0.f, 0.f, 0.f}; }
            f32x4 tcs[2][4][2];
#pragma unroll
            for (int ai = 0; ai < 2; ++ai)
#pragma unroll
                for (int m = 0; m < 4; ++m) { const int pos_ = (rowb + ai * HALF + m * 16) & (SEQ_ - 1); const float* tp_ = is64 ? (T64 + ((size_t)pos_ * 32 + f0) * 2) : (T128 + ((size_t)pos_ * 64 + f0) * 2);
                    tcs[ai][m][0] = *(const f32x4*)tp_; tcs[ai][m][1] = *(const f32x4*)(tp_ + 4); }
#pragma unroll
            for (int ai = 0; ai < 2; ++ai)
#pragma unroll
                for (int m = 0; m < 4; ++m) {
                    const int row = rowb + ai * HALF + m * 16, pos = row & (SEQ_ - 1);
                    const f32x4 cs0 = tcs[ai][m][0], cs1 = tcs[ai][m][1];
                    const float co[4] = {cs0[0], cs0[2], cs1[0], cs1[2]}, si[4] = {cs0[1], cs0[3], cs1[1], cs1[3]};
#pragma unroll
                    for (int bj = 0; bj < 2; ++bj) {
                        const f32x4 x1 = acc[ai][bj][m][0], x2 = acc[ai][bj][m][1]; f32x4 y1, y2;
#pragma unroll
                        for (int i = 0; i < 4; ++i) { y1[i] = x1[i] * co[i] - x2[i] * si[i]; y2[i] = x2[i] * co[i] + x1[i] * si[i]; }
                        const int rc = rt * 256 + bj * HALF + wc * 32 + 8 * fq;
                        bf16_t* dst = (kind == 0) ? (YAB + yab_idx((size_t)row, rc)) : (kind == 1) ? (AK + ((size_t)(b * 8 + (rc >> 6)) * SEQ_ + pos) * 64 + (rc & 63))
                                                  : ((kind == 2 ? RQ : RK) + ((size_t)(b * 4 + (rc >> 7)) * SEQ_ + pos) * 128 + (rc & 127));
                        *(u32x4*)dst = pk8(y1, y2);
                        if (kind == 1) { ks[bj][0] += y1; ks[bj][1] += y2; }
                        if (kind == 3) {
                            const int hh = rt * 2 + bj; const float kd = __builtin_amdgcn_exp2f((float)(127 - (pos & 127)) * lg2gamma(hh));
                            *(u32x4*)(RKT + ((size_t)(b * 4 + hh) * SEQ_ + pos) * 128 + (rc & 127)) = pk8(y1 * kd, y2 * kd);
                        }
                    }
                }
            if (kind == 1) {
                const int blk = u.pm & 15;
#pragma unroll
                for (int bj = 0; bj < 2; ++bj)
#pragma unroll
                    for (int n = 0; n < 2; ++n)
#pragma unroll
                        for (int i = 0; i < 4; ++i) {
                            float s = ks[bj][n][i];
#pragma unroll
                            for (int o_ = 1; o_ < 16; o_ <<= 1) s += __builtin_bit_cast(float, __builtin_amdgcn_ds_bpermute((fq * 16 + (fr ^ o_)) << 2, __builtin_bit_cast(int, s)));
                            if (fr == 0) atomicAdd(KMEAN + (size_t)(b * 16 + blk) * 512 + rt * 256 + bj * HALF + wc * 32 + 8 * fq + 4 * n + i, s);
                        }
            }
        } else if (pn < 18) {
            const int rt = pn - 14;
#pragma unroll
            for (int ai = 0; ai < 2; ++ai)
#pragma unroll
                for (int m = 0; m < 4; ++m) {
                    const int row = rowb + ai * HALF + m * 16;
#pragma unroll
                    for (int bj = 0; bj < 2; ++bj) {
                        const int rc = rt * 256 + bj * HALF + wc * 32 + 8 * fq; f32x4 v0 = acc[ai][bj][m][0], v1 = acc[ai][bj][m][1];
#pragma unroll
                        for (int i = 0; i < 4; ++i) { v0[i] = v0[i] * sigmoidf_(v0[i]); v1[i] = v1[i] * sigmoidf_(v1[i]); }
                        *(u32x4*)(RG + (size_t)row * 1024 + rc) = pk8(v0, v1);
                    }
                }
        } else {
            const int q = pn - 18;
#pragma unroll
            for (int ai = 0; ai < 2; ++ai)
#pragma unroll
                for (int m = 0; m < 4; ++m) {
                    const int row = rowb + ai * HALF + m * 16; unsigned wq[4];
#pragma unroll
                    for (int bj = 0; bj < 2; ++bj) { const f32x4 ga = acc[ai][bj][m][0], gb = acc[ai][bj][m][1];
#pragma unroll
                        for (int i = 0; i < 4; ++i) { const float k255 = 1.0f / 255.0f;
                            const float sa = __builtin_amdgcn_rcpf(__builtin_fmaf(__builtin_amdgcn_exp2f(ga[i]), k255, k255)), sb = fmaxf(__builtin_amdgcn_rcpf(__builtin_fmaf(__builtin_amdgcn_exp2f(gb[i]), k255, k255)), 1.0f);
                            unsigned& ww = wq[2 * bj + (i >> 1)];
                            if ((i & 1) == 0) { ww = __builtin_amdgcn_cvt_pk_u8_f32(sa, 0u, 0u); ww = __builtin_amdgcn_cvt_pk_u8_f32(sb, 1u, ww); }
                            else { ww = __builtin_amdgcn_cvt_pk_u8_f32(sa, 2u, ww); ww = __builtin_amdgcn_cvt_pk_u8_f32(sb, 3u, ww); } } }
                    const int cg = 128 * q + 32 * wc + 8 * fq;
                    u32x4 w; w.x = wq[0]; w.y = wq[1]; w.z = wq[2]; w.w = wq[3];
                    *(u32x4*)(GR + (size_t)row * 1024 + cg) = w;
                }
        }
    }
};

struct EpiVT {
    static constexpr bool PERM = true, AFTER_DRAIN = false; static constexpr int MID_T = 0;
    bf16_t *AVT, *RVT;
    __device__ __forceinline__ void mid(f32x4 (&)[2][2][4][2], const Unit&, int, int, int, int) const {}
    __device__ __forceinline__ void operator()(const f32x4 (&acc)[2][2][4][2], const Unit& u, int wr, int wc, int fr, int fq) const {
        const bool isa = u.pm < 6; const int rt = isa ? u.pm - 4 : u.pm - 10;
#pragma unroll
        for (int ai = 0; ai < 2; ++ai)
#pragma unroll
            for (int m = 0; m < 4; ++m) {
                const int rc = rt * 256 + ai * HALF + wr * 64 + 32 * (m >> 1) + 8 * (fr >> 2) + 4 * (m & 1) + (fr & 3);
#pragma unroll
                for (int bj = 0; bj < 2; ++bj) {
                    const int t = u.pn * BM + bj * HALF + wc * 32 + 8 * fq, b = t >> 12, pos = t & (SEQ_ - 1);
                    bf16_t* dst = isa ? (AVT + (((size_t)(b * 8 + (rc >> 6)) * 64 + (pos >> 6)) * 64 + (rc & 63)) * 64 + (pos & 63)) : (RVT + (((size_t)(b * 4 + (rc >> 8)) * 32 + (pos >> 7)) * 256 + (rc & 255)) * 128 + (pos & 127));
                    *(u32x4*)dst = pk8(acc[ai][bj][m][0], acc[ai][bj][m][1]);
                }
            }
    }
};

struct EpiKVX {
    static constexpr bool PERM = false, AFTER_DRAIN = false; static constexpr int MID_T = 0;
    bf16_t *KX, *VXT;
    __device__ __forceinline__ void mid(f32x4 (&)[2][2][4][2], const Unit&, int, int, int, int) const {}
    __device__ __forceinline__ void operator()(const f32x4 (&acc)[2][2][4][2], const Unit& u, int wr, int wc, int fr, int fq) const {
        const int pn = u.pn, b = u.pm;
#pragma unroll
        for (int ai = 0; ai < 2; ++ai)
#pragma unroll
            for (int m = 0; m < 4; ++m) {
                const int mt = ai * HALF + wr * 64 + m * 16 + fr;
#pragma unroll
                for (int bj = 0; bj < 2; ++bj) {
                    const int cc = bj * HALF + wc * 32 + 8 * fq;
                    if (pn < 4) *(u32x4*)(KX + ((size_t)(b * 4 + pn) * 256 + mt) * 256 + cc) = pk8(acc[ai][bj][m][0], acc[ai][bj][m][1]);
                    else {
#pragma unroll
                        for (int n = 0; n < 2; ++n) { bf16_t* tb = VXT + (((size_t)(b * 4 + (pn - 4)) * 4 + (mt >> 6)) * 256 + cc + 4 * n) * 64 + (mt & 63); const f32x4 v = acc[ai][bj][m][n];
#pragma unroll
                            for (int i = 0; i < 4; ++i) tb[i * 64] = (bf16_t)f2bf(v[i]); } }
                }
            }
    }
};

__device__ __forceinline__ f32x4 gratio(unsigned a, unsigned b) { return (f32x4){(float)(a & 0xffu) * __builtin_amdgcn_rcpf((float)((a >> 8) & 0xffu)), (float)((a >> 16) & 0xffu) * __builtin_amdgcn_rcpf((float)(a >> 24)),
                                                                                       (float)(b & 0xffu) * __builtin_amdgcn_rcpf((float)((b >> 8) & 0xffu)), (float)((b >> 16) & 0xffu) * __builtin_amdgcn_rcpf((float)(b >> 24))}; }
__device__ __forceinline__ f32x4 gsb(unsigned a, unsigned b) { const float k = 1.0f / 255.0f; return (f32x4){(float)((a >> 8) & 0xffu) * k, (float)(a >> 24) * k, (float)((b >> 8) & 0xffu) * k, (float)(b >> 24) * k}; }
struct EpiMerge {
    static constexpr bool PERM = false, AFTER_DRAIN = false; static constexpr int MID_T = 8;
    const bf16_t *GR, *GS; bf16_t* OUT;
    __device__ __forceinline__ void load_gates(u32x4 (&g)[4][2], int ai, const Unit& u, int wr, int wc, int fr, int fq) const {
#pragma unroll
        for (int m = 0; m < 4; ++m)
#pragma unroll
            for (int bj = 0; bj < 2; ++bj) g[m][bj] = *(const u32x4*)(GR + (size_t)(u.pm * BM + ai * HALF + wr * 64 + m * 16 + fr) * 1024 + u.pn * BM + bj * HALF + wc * 32 + 8 * fq);
    }
    __device__ __forceinline__ void mid(f32x4 (&acc)[2][2][4][2], const Unit& u, int wr, int wc, int fr, int fq) const {
#pragma unroll
        for (int ai = 0; ai < 2; ++ai)
#pragma unroll
            for (int mp = 0; mp < 2; ++mp) {
                u32x4 g[2][2];
#pragma unroll
                for (int mm = 0; mm < 2; ++mm)
#pragma unroll
                    for (int bj = 0; bj < 2; ++bj) g[mm][bj] = *(const u32x4*)(GR + (size_t)(u.pm * BM + ai * HALF + wr * 64 + (2 * mp + mm) * 16 + fr) * 1024 + u.pn * BM + bj * HALF + wc * 32 + 8 * fq);
#pragma unroll
                for (int mm = 0; mm < 2; ++mm)
#pragma unroll
                    for (int bj = 0; bj < 2; ++bj) { acc[ai][bj][2 * mp + mm][0] *= gratio(g[mm][bj].x, g[mm][bj].y); acc[ai][bj][2 * mp + mm][1] *= gratio(g[mm][bj].z, g[mm][bj].w); }
            }
    }
    __device__ __forceinline__ void operator()(const f32x4 (&acc)[2][2][4][2], const Unit& u, int wr, int wc, int fr, int fq) const {
#pragma unroll
        for (int ai = 0; ai < 2; ++ai) {
            u32x4 g[4][2]; load_gates(g, ai, u, wr, wc, fr, fq);
#pragma unroll
            for (int m = 0; m < 4; ++m) {
                const int row = u.pm * BM + ai * HALF + wr * 64 + m * 16 + fr;
#pragma unroll
                for (int bj = 0; bj < 2; ++bj) { const int c = u.pn * BM + bj * HALF + wc * 32 + 8 * fq;
                    *(u32x4*)(OUT + (size_t)row * 1024 + c) = pk8(acc[ai][bj][m][0] * gsb(g[m][bj].x, g[m][bj].y), acc[ai][bj][m][1] * gsb(g[m][bj].z, g[m][bj].w)); }
            }
        }
    }
};

template <bool BASE_BF16, bool OUT_BF16> struct EpiResid {
    static constexpr bool PERM = false, AFTER_DRAIN = false; static constexpr int MID_T = 0;
    const void* base; void* out; float* SSQ;
    __device__ __forceinline__ void mid(f32x4 (&)[2][2][4][2], const Unit&, int, int, int, int) const {}
    __device__ __forceinline__ void operator()(const f32x4 (&acc)[2][2][4][2], const Unit& u, int wr, int wc, int fr, int fq) const {
#pragma unroll
        for (int ai = 0; ai < 2; ++ai) {
            f32x4 b0[4][2], b1[4][2];
#pragma unroll
            for (int m = 0; m < 4; ++m)
#pragma unroll
                for (int bj = 0; bj < 2; ++bj) { const size_t off = (size_t)(u.pm * BM + ai * HALF + wr * 64 + m * 16 + fr) * DM_ + u.pn * BM + bj * HALF + wc * 32 + 8 * fq;
                    if (BASE_BF16) { const u32x4 w = *(const u32x4*)((const bf16_t*)base + off); b0[m][bj] = unlo(w); b1[m][bj] = unhi(w); }
                    else { b0[m][bj] = __builtin_nontemporal_load((const f32x4*)((const float*)base + off)); b1[m][bj] = __builtin_nontemporal_load((const f32x4*)((const float*)base + off + 4)); } }
            float sq[4];
#pragma unroll
            for (int m = 0; m < 4; ++m) {
                const int row = u.pm * BM + ai * HALF + wr * 64 + m * 16 + fr; float ss = 0.f;
#pragma unroll
                for (int bj = 0; bj < 2; ++bj) { const int c = u.pn * BM + bj * HALF + wc * 32 + 8 * fq; const size_t off = (size_t)row * DM_ + c;
                    const f32x4 x0 = b0[m][bj] + acc[ai][bj][m][0], x1 = b1[m][bj] + acc[ai][bj][m][1];
                    ss += ((x0[0] * x0[0] + x0[1] * x0[1]) + (x0[2] * x0[2] + x0[3] * x0[3])) + ((x1[0] * x1[0] + x1[1] * x1[1]) + (x1[2] * x1[2] + x1[3] * x1[3]));
                    if (OUT_BF16) *(u32x4*)((bf16_t*)out + off) = pk8(x0, x1); else { *(f32x4*)((float*)out + off) = x0; *(f32x4*)((float*)out + off + 4) = x1; } }
                ss += __shfl_xor(ss, 16); ss += __shfl_xor(ss, 32); sq[m] = ss;
            }
            SSQ[(size_t)(u.pm * BM + ai * HALF + wr * 64 + fq * 16 + fr) * 16 + u.pn * 4 + wc] = fq == 0 ? sq[0] : fq == 1 ? sq[1] : fq == 2 ? sq[2] : sq[3];
        }
    }
};
__device__ __forceinline__ float row_rstd(const float* SSQ, int row) {
    const f32x4 a = *(const f32x4*)(SSQ + (size_t)row * 16), b = *(const f32x4*)(SSQ + (size_t)row * 16 + 4), c = *(const f32x4*)(SSQ + (size_t)row * 16 + 8), d = *(const f32x4*)(SSQ + (size_t)row * 16 + 12);
    const float s = (((a[0] + a[1]) + (a[2] + a[3])) + ((b[0] + b[1]) + (b[2] + b[3]))) + (((c[0] + c[1]) + (c[2] + c[3])) + ((d[0] + d[1]) + (d[2] + d[3])));
    return __builtin_amdgcn_rsqf(s * (1.0f / 1024.0f) + 1e-6f);
}
template <bool WITH_MS = false> __device__ __forceinline__ void rows_rstd(const float* SSQ, const Unit& u, int wr, int fr, int fq, float (&rs)[2][4], float (*ms)[4] = nullptr) {
    f32x4 p[2][4];
#pragma unroll
    for (int ai = 0; ai < 2; ++ai)
#pragma unroll
        for (int m = 0; m < 4; ++m) p[ai][m] = *(const f32x4*)(SSQ + (size_t)(u.pm * BM + ai * HALF + wr * 64 + m * 16 + fr) * 16 + 4 * fq);
#pragma unroll
    for (int ai = 0; ai < 2; ++ai)
#pragma unroll
        for (int m = 0; m < 4; ++m) { float t = (p[ai][m][0] + p[ai][m][1]) + (p[ai][m][2] + p[ai][m][3]); t += __shfl_xor(t, 16); t += __shfl_xor(t, 32); const float v_ = t * (1.0f / 1024.0f) + 1e-6f; rs[ai][m] = __builtin_amdgcn_rsqf(v_); if (WITH_MS) ms[ai][m] = v_; }
}
struct EpiRowScale {
    static constexpr bool PERM = false, AFTER_DRAIN = false; static constexpr int MID_T = 0;
    const float* SSQ; bf16_t* OUT; float scale;
    __device__ __forceinline__ void mid(f32x4 (&)[2][2][4][2], const Unit&, int, int, int, int) const {}
    __device__ __forceinline__ void operator()(const f32x4 (&acc)[2][2][4][2], const Unit& u, int wr, int wc, int fr, int fq) const {
        float rsv[2][4]; rows_rstd(SSQ, u, wr, fr, fq, rsv);
#pragma unroll
        for (int ai = 0; ai < 2; ++ai)
#pragma unroll
            for (int m = 0; m < 4; ++m) {
                const int row = u.pm * BM + ai * HALF + wr * 64 + m * 16 + fr; const float rs = rsv[ai][m] * scale;
#pragma unroll
                for (int bj = 0; bj < 2; ++bj) { const int c = u.pn * BM + bj * HALF + wc * 32 + 8 * fq; *(u32x4*)(OUT + (size_t)row * DM_ + c) = pk8(acc[ai][bj][m][0] * rs, acc[ai][bj][m][1] * rs); }
            }
    }
};
struct EpiSwiGLU {
    static constexpr bool PERM = false, AFTER_DRAIN = false; static constexpr int MID_T = 0;
    const float* SSQ; bf16_t* OUT;
    __device__ __forceinline__ void mid(f32x4 (&)[2][2][4][2], const Unit&, int, int, int, int) const {}
    __device__ __forceinline__ void operator()(const f32x4 (&acc)[2][2][4][2], const Unit& u, int wr, int wc, int fr, int fq) const {
        float rsv[2][4], msv[2][4]; rows_rstd<true>(SSQ, u, wr, fr, fq, rsv, msv);
#pragma unroll
        for (int ai = 0; ai < 2; ++ai)
#pragma unroll
            for (int m = 0; m < 4; ++m) {
                const int row = u.pm * BM + ai * HALF + wr * 64 + m * 16 + fr; const float c1 = -rsv[ai][m] * 1.4426950408889634f, ms = msv[ai][m]; f32x4 a[2];
#pragma unroll
                for (int bj = 0; bj < 2; ++bj) { const f32x4 g = acc[ai][bj][m][0], up = acc[ai][bj][m][1];
#pragma unroll
                    for (int i = 0; i < 4; ++i) a[bj][i] = (g[i] * up[i]) * __builtin_amdgcn_rcpf(__builtin_fmaf(__builtin_amdgcn_exp2f(g[i] * c1), ms, ms)); }
                __builtin_nontemporal_store(pk8(a[0], a[1]), (u32x4*)(OUT + (size_t)row * 2816 + 128 * u.pn + 32 * wc + 8 * fq));
            }
    }
};

template <class Epi, class Sched, bool ALIGN_EPI = false, bool SP2 = false>
__device__ __forceinline__ void gemm_phase(PG8_LAS unsigned char* lds, const Gemm g, const Sched& S, const Epi& E, int wave_s) {
    int tid_; asm volatile("v_mbcnt_lo_u32_b32 %0, -1, 0\n\tv_mbcnt_hi_u32_b32 %0, -1, %0" : "=v"(tid_)); tid_ += wave_s * 64;
    const int tid = tid_, wid = __builtin_amdgcn_readfirstlane(tid >> 6), lane = tid & 63, wr = wid >> 2, wc = wid & 3, fr = lane & 15, fq = lane >> 4;
    const int K = g.K, nt = K / BK;
    unsigned voffA[2], voffB[2];
#pragma unroll
    for (int i = 0; i < 2; ++i) { int R, C; stage_rc(tid * 16 + i * 8192, R, C); const int Rb = Epi::PERM ? ((R & ~31) + perm32(R & 31)) : R;
        voffA[i] = g.ablk ? (unsigned)(R * BK + C) * 2u : (unsigned)(R * K + C) * 2u; voffB[i] = (unsigned)(Rb * K + C) * 2u; }
    const size_t kstep = (size_t)(BK * 2);
    const size_t hstep = (size_t)HALF * K * 2;
    const size_t tstep = 2 * hstep;
    const size_t kstepA = g.ablk ? (size_t)BM * BK * 2 : kstep, hstepA = g.ablk ? (size_t)HALF * BK * 2 : hstep, tstepA = g.ablk ? (size_t)BM * K * 2 : tstep;
    const unsigned ldsw = (unsigned)wid * 1024u;
    const int aoff = lds_byte(wr * 64 + fr, fq * 8), boff = lds_byte(wc * 32 + fr, fq * 8);
#define PG8_SA(b, h) (((b) * 2 + (h)) * HTB)
#define PG8_SB(b, h) ((4 + (b) * 2 + (h)) * HTB)
#define PG8_STAGE(bufoff, gbase, voff) do { _Pragma("unroll") for (int _i = 0; _i < 2; ++_i) \
        __builtin_amdgcn_global_load_lds((const unsigned*)((const char*)(gbase) + (voff)[_i]), (PG8_LAS unsigned*)(lds + (bufoff) + ldsw + _i * 8192), 16, 0, 0); } while (0)
#define PG8_LDA(dst, b, h) do { _Pragma("unroll") for (int m = 0; m < 4; ++m) _Pragma("unroll") for (int k = 0; k < 2; ++k) dst[m][k] = *(const PG8_LAS bf16x8*)(lds + PG8_SA(b, h) + aoff + m * 2048 + k * 1024); } while (0)
#define PG8_LDB(dst, b, h) do { _Pragma("unroll") for (int n = 0; n < 2; ++n) _Pragma("unroll") for (int k = 0; k < 2; ++k) dst[n][k] = *(const PG8_LAS bf16x8*)(lds + PG8_SB(b, h) + boff + n * 2048 + k * 1024); } while (0)
#define PG8_MMA(ai, bj, At, Bt) do { __builtin_amdgcn_s_setprio(1); _Pragma("unroll") for (int m = 0; m < 4; ++m) _Pragma("unroll") for (int n = 0; n < 2; ++n) _Pragma("unroll") for (int k = 0; k < 2; ++k) \
        acc[ai][bj][m][n] = __builtin_amdgcn_mfma_f32_16x16x32_bf16(Bt[n][k], At[m][k], acc[ai][bj][m][n], 0, 0, 0); __builtin_amdgcn_s_setprio(0); } while (0)
#define PG8_WAIT_V(n) asm volatile("s_waitcnt vmcnt(" #n ")" ::: "memory")
#define PG8_WAIT_L(n) asm volatile("s_waitcnt lgkmcnt(" #n ")" ::: "memory")
#define PG8_BAR __builtin_amdgcn_s_barrier()
#define PG8_SCHED __builtin_amdgcn_sched_barrier(0)
    Unit cur, nxt; int ui = 0;
    if (!S.next(0, cur)) return;
    f32x4 acc[2][2][4][2];
#pragma unroll
    for (int a = 0; a < 2; ++a)
#pragma unroll
        for (int b = 0; b < 2; ++b)
#pragma unroll
            for (int m = 0; m < 4; ++m)
#pragma unroll
                for (int n = 0; n < 2; ++n) acc[a][b][m][n] = (f32x4){0.f, 0.f, 0.f, 0.f};
    bf16x8 At[4][2], B0[2][2], B1[2][2];
    const char* cA = (const char*)g.A + (size_t)cur.pm * tstepA; const char* cB = (const char*)g.Bt + (size_t)cur.pn * tstep;
    S.a_ready(cur);
    if constexpr (SP2) {
        PG8_STAGE(PG8_SB(0, 0), cB, voffB); PG8_STAGE(PG8_SB(0, 1), cB + hstep, voffB); PG8_STAGE(PG8_SA(0, 0), cA, voffA); PG8_STAGE(PG8_SA(0, 1), cA + hstepA, voffA);
        if (wr == 1) PG8_BAR;
        PG8_WAIT_V(2); PG8_BAR;
        PG8_STAGE(PG8_SB(1, 0), cB + kstep, voffB); PG8_STAGE(PG8_SA(1, 0), cA + kstepA, voffA); PG8_STAGE(PG8_SB(1, 1), cB + hstep + kstep, voffB);
        PG8_WAIT_V(6); PG8_BAR;
    } else {
        PG8_STAGE(PG8_SB(0, 0), cB, voffB); PG8_STAGE(PG8_SA(0, 0), cA, voffA); PG8_STAGE(PG8_SB(0, 1), cB + hstep, voffB); PG8_STAGE(PG8_SA(0, 1), cA + hstepA, voffA);
        if (wr == 1) PG8_BAR;
        PG8_WAIT_V(4); PG8_BAR;
        PG8_STAGE(PG8_SB(1, 0), cB + kstep, voffB); PG8_STAGE(PG8_SA(1, 0), cA + kstepA, voffA); PG8_STAGE(PG8_SB(1, 1), cB + hstep + kstep, voffB);
        PG8_WAIT_V(6); PG8_BAR;
    }
    for (;;) {
        const bool has_next = S.next(ui + 1, nxt);
        const char* nA = has_next ? (const char*)g.A + (size_t)nxt.pm * tstepA : cA; const char* nB = has_next ? (const char*)g.Bt + (size_t)nxt.pn * tstep : cB;
        for (int t = 0; t < nt; t += 2) {
            const bool last = (t == nt - 2);
            if constexpr (Epi::MID_T > 0) { if (t == Epi::MID_T) E.mid(acc, cur, wr, wc, fr, fq); }
            const char* a1 = cA + (size_t)(t + 1) * kstepA;
            const char* a2 = last ? nA : cA + (size_t)(t + 2) * kstepA; const char* b2 = last ? nB : cB + (size_t)(t + 2) * kstep;
            const char* a3 = a2 + kstepA; const char* b3 = b2 + kstep;
            if (last && has_next) S.a_ready(nxt);
            if constexpr (SP2) {
            PG8_LDB(B0, 0, 0); PG8_LDB(B1, 0, 1); PG8_SCHED; PG8_LDA(At, 0, 0); PG8_STAGE(PG8_SA(1, 1), a1 + hstepA, voffA);
            PG8_WAIT_V(8); PG8_WAIT_L(0); PG8_BAR; PG8_MMA(0, 0, At, B0); PG8_MMA(0, 1, At, B1); PG8_BAR; PG8_SCHED;
            PG8_LDA(At, 0, 1); PG8_STAGE(PG8_SB(0, 0), b2, voffB); PG8_STAGE(PG8_SB(0, 1), b2 + hstep, voffB); PG8_STAGE(PG8_SA(0, 0), a2, voffA);
            PG8_WAIT_V(8); PG8_WAIT_L(0); PG8_BAR; PG8_MMA(1, 0, At, B0); PG8_MMA(1, 1, At, B1); PG8_BAR; PG8_SCHED;
            PG8_LDB(B0, 1, 0); PG8_LDB(B1, 1, 1); PG8_SCHED; PG8_LDA(At, 1, 0); PG8_STAGE(PG8_SA(0, 1), a2 + hstepA, voffA);
            PG8_WAIT_V(8); PG8_WAIT_L(0); PG8_BAR; PG8_MMA(0, 0, At, B0); PG8_MMA(0, 1, At, B1); PG8_BAR; PG8_SCHED;
            PG8_LDA(At, 1, 1); PG8_STAGE(PG8_SB(1, 0), b3, voffB); PG8_STAGE(PG8_SB(1, 1), b3 + hstep, voffB); PG8_STAGE(PG8_SA(1, 0), a3, voffA);
            PG8_WAIT_V(8); PG8_WAIT_L(0); PG8_BAR; PG8_MMA(1, 0, At, B0); PG8_MMA(1, 1, At, B1); PG8_BAR; PG8_SCHED;
            } else {
            PG8_LDB(B0, 0, 0); PG8_SCHED; PG8_LDA(At, 0, 0); PG8_STAGE(PG8_SA(1, 1), a1 + hstepA, voffA);
            PG8_WAIT_L(8); PG8_BAR; PG8_WAIT_L(0); PG8_MMA(0, 0, At, B0); PG8_BAR; PG8_SCHED;
            PG8_LDB(B1, 0, 1); PG8_STAGE(PG8_SB(0, 0), b2, voffB);
            PG8_BAR; PG8_WAIT_L(0); PG8_MMA(0, 1, At, B1); PG8_BAR;
            PG8_LDA(At, 0, 1); PG8_STAGE(PG8_SA(0, 0), a2, voffA);
            PG8_BAR; PG8_WAIT_L(0); PG8_MMA(1, 0, At, B0); PG8_BAR; PG8_SCHED;
            PG8_STAGE(PG8_SB(0, 1), b2 + hstep, voffB);
            PG8_WAIT_V(6); PG8_BAR; PG8_MMA(1, 1, At, B1); PG8_BAR;
            PG8_LDB(B0, 1, 0); PG8_SCHED; PG8_LDA(At, 1, 0); PG8_STAGE(PG8_SA(0, 1), a2 + hstepA, voffA);
            PG8_WAIT_L(8); PG8_BAR; PG8_WAIT_L(0); PG8_MMA(0, 0, At, B0); PG8_BAR; PG8_SCHED;
            PG8_LDB(B1, 1, 1); PG8_STAGE(PG8_SB(1, 0), b3, voffB);
            PG8_BAR; PG8_WAIT_L(0); PG8_MMA(0, 1, At, B1); PG8_BAR;
            PG8_LDA(At, 1, 1); PG8_STAGE(PG8_SA(1, 0), a3, voffA);
            PG8_BAR; PG8_WAIT_L(0); PG8_MMA(1, 0, At, B0); PG8_BAR; PG8_SCHED;
            PG8_STAGE(PG8_SB(1, 1), b3 + hstep, voffB);
            PG8_WAIT_V(6); PG8_BAR; PG8_MMA(1, 1, At, B1); PG8_BAR;
            }
        }
        if constexpr (ALIGN_EPI) { if (wr == 0) PG8_BAR; }
        if constexpr (!Epi::AFTER_DRAIN) { E(acc, cur, wr, wc, fr, fq); S.done(cur); }
        if (!has_next) break;
#pragma unroll
        for (int a = 0; a < 2; ++a)
#pragma unroll
            for (int b = 0; b < 2; ++b)
#pragma unroll
                for (int m = 0; m < 4; ++m)
#pragma unroll
                    for (int n = 0; n < 2; ++n) acc[a][b][m][n] = (f32x4){0.f, 0.f, 0.f, 0.f};
        cur = nxt; cA = nA; cB = nB; ++ui;
        if constexpr (ALIGN_EPI) { if (wr == 1) PG8_BAR; }
    }
    PG8_WAIT_V(0);
    if constexpr (!ALIGN_EPI) { if (wr == 0) PG8_BAR; }
    PG8_BAR;
    if constexpr (Epi::AFTER_DRAIN) { E.fused(acc, cur, wr, wc, fr, fq, lds, wid, lane); S.done(cur); }
#undef PG8_SA
#undef PG8_SB
#undef PG8_STAGE
#undef PG8_LDA
#undef PG8_LDB
#undef PG8_MMA
#undef PG8_WAIT_V
#undef PG8_WAIT_L
#undef PG8_BAR
#undef PG8_SCHED
}
}


constexpr int NWAVES = 8;
#ifndef PROBE_PHASE
#define PROBE_PHASE (-1)
#endif
constexpr int BATCH = 8, SEQ = 4096, DM = 1024, MTOK = BATCH * SEQ, MEML = 256, MMEM = BATCH * MEML;
constexpr int INC = 6656, DFF = 2816, NCHUNK = 32;
constexpr float EPS = 1e-6f, LOG2E = 1.4426950408889634f;
#define NEG_INF (-__builtin_inff())

constexpr size_t MiB = 1u << 20;
constexpr size_t WS_CTL = 0, WS_KMEAN = 256 * 1024, CTL_ZERO_BYTES = 512 * 1024;
constexpr size_t WS_T64 = 1 * MiB, WS_T128 = 2 * MiB, WS_MEMN = 4 * MiB, WS_KX = 8 * MiB, WS_VXT = 12 * MiB;
constexpr size_t WS_WIN = 16 * MiB, WS_WAB = 29 * MiB, WS_WOUT = 32 * MiB, WS_WXQ = 34 * MiB, WS_WXKV = 36 * MiB, WS_WXO = 40 * MiB, WS_WGU = 42 * MiB, WS_WDN = 53 * MiB;
constexpr size_t WS_H = 60 * MiB, WS_YAB = 124 * MiB, WS_AK = 220 * MiB, WS_AVT = 252 * MiB, WS_RQ = 284 * MiB, WS_RK = 316 * MiB, WS_RKT = 348 * MiB, WS_RVT = 380 * MiB, WS_RG = 444 * MiB, WS_END = 508 * MiB;
constexpr size_t WS_ST = WS_H, WS_QX = WS_H, WS_MERGED = WS_AK, WS_OX = WS_AK, WS_X1 = 284 * MiB, WS_SSQ1 = 412 * MiB, WS_SSQ2 = 414 * MiB, WS_SSQ3 = 416 * MiB, WS_XB = WS_RG, WS_ACT = 60 * MiB;
static_assert(WS_WDN + (size_t)DM * DFF * 2 <= WS_H && WS_ACT + (size_t)MTOK * DFF * 2 <= WS_X1 && WS_X1 + (size_t)MTOK * DM * 4 <= WS_SSQ1 && WS_SSQ3 + 2 * MiB <= WS_XB, "d_ws map");
constexpr int CW_TMO = 0, CW_CODE = 1, CW_BAR = 4096, CW_Q = 8192, CW_CNT = 16384;

constexpr int RING_OFF = 0, RING_BYTES = 131072;
constexpr int LDSCTL_OFF = RING_BYTES, MISC_OFF = LDSCTL_OFF + 320;
constexpr int LDS_BYTES = 147456;

#define GAS __attribute__((address_space(1)))
#define LAS __attribute__((address_space(3)))
typedef unsigned short bf16;
typedef unsigned v4u __attribute__((ext_vector_type(4)));
typedef float f32x4 __attribute__((ext_vector_type(4)));
typedef short bf16x8 __attribute__((ext_vector_type(8)));
typedef GAS unsigned gu32;
typedef GAS unsigned long long gu64;
#define RLX_AGENT __ATOMIC_RELAXED, __HIP_MEMORY_SCOPE_AGENT
#define LDS_WAIT() asm volatile("s_waitcnt lgkmcnt(0)" ::: "memory")
#define VM_WAIT() asm volatile("s_waitcnt vmcnt(0)" ::: "memory")
__device__ __forceinline__ unsigned long long rt() { return __builtin_amdgcn_s_memrealtime(); }
__device__ __forceinline__ unsigned pk2(float lo, float hi) { return pg8::pk2(lo, hi); }
__device__ __forceinline__ unsigned f2bf(float f) { return pg8::f2bf(f); }

#define XB_TMO      128
#define XB_XCNT(j)  (256  + 64 * (j))
#define XB_XSUB(j)  (1280 + 64 * (j))
#define XB_XGEN(j)  (2304 + 64 * (j))
#define XB_TOP      3328
#define XB_TOPGEN   3392
#define XCD_BAR_WORDS 3456
#define XB_SPIN_CAP (1u << 18)

__device__ __forceinline__ unsigned xb_ld(unsigned* p)              { return __hip_atomic_load(p, __ATOMIC_RELAXED, __HIP_MEMORY_SCOPE_AGENT); }
__device__ __forceinline__ unsigned xb_add(unsigned* p, unsigned v) { return __hip_atomic_fetch_add(p, v, __ATOMIC_RELAXED, __HIP_MEMORY_SCOPE_AGENT); }
__device__ __forceinline__ unsigned xb_xcc_id() { return (unsigned)__builtin_amdgcn_s_getreg((3 << 11) | 20) & 0xFu; }
#define XB_SPIN(cond, bar) do { unsigned _sp = 0; while (cond) { __builtin_amdgcn_s_sleep(1); \
    if ((++_sp & 255u) == 0u) { if (xb_ld(&(bar)[XB_TMO])) break; if (_sp > XB_SPIN_CAP) { atomicAdd(&(bar)[XB_TMO], 1u); break; } } } } while (0)

struct XcdBarrier {
    unsigned* bar; unsigned x;
    volatile LAS unsigned* st;
};

__device__ __forceinline__ XcdBarrier xcd_barrier_post(unsigned* bar, volatile LAS unsigned* st) {
    XcdBarrier b; b.bar = bar; b.x = xb_xcc_id(); b.st = st;
    if (threadIdx.x == 0) (void)xb_add(&bar[XB_XCNT(b.x)], 1u);
    return b;
}
__device__ __forceinline__ void xcd_barrier_complete(unsigned* bar, unsigned x, unsigned& nloc, unsigned& nx) {
    const unsigned G = gridDim.x * gridDim.y * gridDim.z;
    unsigned sum, cnt, mine, sp = 0u;
    for (;;) {
        sum = 0u; cnt = 0u; mine = 0u;
#pragma unroll
        for (unsigned j = 0; j < 16; ++j) { const unsigned c = xb_ld(&bar[XB_XCNT(j)]); sum += c; cnt += (c > 0u) ? 1u : 0u; mine = (j == x) ? c : mine; }
        if (sum == G) break;
        __builtin_amdgcn_s_sleep(1);
        if ((++sp & 255u) == 0u) { if (xb_ld(&bar[XB_TMO])) break; if (sp > XB_SPIN_CAP) { atomicAdd(&bar[XB_TMO], 1u); break; } }
    }
    nloc = mine > 0u ? mine : 1u; nx = cnt > 0u ? cnt : 1u;
}

__device__ __forceinline__ void xcd_barrier(const XcdBarrier& b, bool leader_thread) {
    asm volatile("s_waitcnt vmcnt(0)" ::: "memory");
    __syncthreads();
    if (leader_thread) {
        unsigned* bar = b.bar;
        __builtin_amdgcn_s_waitcnt(0);
        unsigned nloc = b.st[0], nx = b.st[1];
        if (nloc == 0u) { xcd_barrier_complete(bar, b.x, nloc, nx); b.st[0] = nloc; b.st[1] = nx; }
        const unsigned old = xb_add(&bar[XB_XSUB(b.x)], 1u);
        const unsigned gen = old / nloc;
        if (old + 1u == (gen + 1u) * nloc) {
            __builtin_amdgcn_fence(__ATOMIC_RELEASE, "agent");
            asm volatile("s_waitcnt vmcnt(0)" ::: "memory");
            const unsigned og = xb_add(&bar[XB_TOP], 1u);
            const unsigned tg = og / nx;
            if (og + 1u == (tg + 1u) * nx) xb_add(&bar[XB_TOPGEN], 1u);
            else XB_SPIN(xb_ld(&bar[XB_TOPGEN]) == tg, bar);
            __builtin_amdgcn_fence(__ATOMIC_ACQUIRE, "agent");
            xb_add(&bar[XB_XGEN(b.x)], 1u);
            asm volatile("s_waitcnt vmcnt(0)" ::: "memory");
        } else {
            XB_SPIN(xb_ld(&bar[XB_XGEN(b.x)]) == gen, bar);
            __builtin_amdgcn_fence(__ATOMIC_ACQUIRE, "agent");
            asm volatile("s_waitcnt vmcnt(0)" ::: "memory");
        }
    }
    __syncthreads();
}

__device__ __forceinline__ int lane_id_v() { int l; asm volatile("v_mbcnt_lo_u32_b32 %0, -1, 0\n\tv_mbcnt_hi_u32_b32 %0, -1, %0" : "=v"(l)); return l; }
__device__ __forceinline__ float wave_sum(float v) {
#pragma unroll
    for (int o = 1; o < 64; o <<= 1) v += __shfl_xor(v, o);
    return v;
}
__device__ __forceinline__ void col_map(int kind, int p, int& which, int& col, float& sc) {
    const int j = p & 31, jn = j >> 4, jfq = (j >> 2) & 3, ji = j & 3, plain = (p & ~31) + 8 * jfq + 4 * jn + ji;
    which = 0; col = plain; sc = 1.0f;
    if (kind == 1) {
        const int pn = p >> 8, cp = p & 255;
        if (pn < 4) { const int rc = (pn & 1) * 256 + cp, hh = rc >> 6, oo = rc & 63, f = 16 * (oo >> 5) + (oo & 15), half = (oo >> 4) & 1; col = (pn >> 1) * 512 + hh * 64 + half * 32 + f; if (pn < 2) sc = 0.125f * LOG2E; }
        else if (pn < 6) { col = 1024 + (plain - 4 * 256); }
        else if (pn < 10) { const int rc = (pn & 1) * 256 + cp, hh = rc >> 7, oo = rc & 127, f = 16 * (oo >> 5) + (oo & 15), half = (oo >> 4) & 1; col = 1536 + ((pn - 6) >> 1) * 512 + hh * 128 + half * 64 + f; if (pn >= 8) sc = 0.08838834764831845f; }
        else if (pn < 18) { col = 2560 + (plain - 10 * 256); }
        else { const int q = pn - 18, bj = cp >> 7, wc = (cp >> 5) & 3; col = (jn ? 5632 : 4608) + 128 * q + 32 * wc + 8 * jfq + 4 * bj + ji; sc = -LOG2E; }
    } else if (kind == 2) {
        const int q = p >> 8, cp = p & 255, bj = cp >> 7, wc = (cp >> 5) & 3; which = jn; col = 128 * q + 32 * wc + 8 * jfq + 4 * bj + ji;
    }
}
__device__ __forceinline__ void p0_tile128(const float* s0, const float* s1, int N, int Np, int kind, bf16* WT, int ldt, int koff, LAS unsigned char* lds, int item, int tid, const float* gk = nullptr) {
    const int nblk = Np / 128, kb = item / nblk, nb = item % nblk, k0 = 128 * kb, n0 = 128 * nb, lane = tid & 63, w = tid >> 6, q8 = lane & 7, kl = lane >> 3;
    const float* srcg[4]; float scg[4];
#pragma unroll
    for (int g = 0; g < 4; ++g) { int which, col; float sc; col_map(kind, n0 + 32 * g + 4 * q8, which, col, sc); srcg[g] = (which ? s1 : s0) + col; scg[g] = sc; }
    f32x4 v[8];
#pragma unroll
    for (int i = 0; i < 8; ++i) v[i] = __builtin_nontemporal_load((const f32x4*)(srcg[i & 3] + (size_t)(k0 + 16 * w + 2 * kl + (i >> 2)) * N));
    LAS bf16* T = (LAS bf16*)lds;
#pragma unroll
    for (int g = 0; g < 4; ++g) { const int k = 16 * w + 2 * kl; const float g0 = gk ? scg[g] * gk[k0 + k] : scg[g], g1 = gk ? scg[g] * gk[k0 + k + 1] : scg[g];
#pragma unroll
        for (int e = 0; e < 4; ++e) *(LAS unsigned*)(T + (32 * g + 4 * q8 + e) * 132 + k) = pg8::pk2(v[g][e] * g0, v[g + 4][e] * g1); }
    __syncthreads();
#pragma unroll
    for (int j = 0; j < 4; ++j) { const int c = tid + 512 * j, row = c >> 4, ch = c & 15;
        const unsigned long long lo = *(const LAS unsigned long long*)(lds + row * 264 + ch * 16), hi = *(const LAS unsigned long long*)(lds + row * 264 + ch * 16 + 8);
        v4u o; o.x = (unsigned)lo; o.y = (unsigned)(lo >> 32); o.z = (unsigned)hi; o.w = (unsigned)(hi >> 32);
        *(GAS v4u*)(WT + (size_t)(n0 + row) * ldt + koff + k0 + 8 * ch) = o; }
    __syncthreads();
}
constexpr int I_IN = 8 * (INC / 128), I_KV = 8 * 16, I_A = 4 * 8, I_B = 8 * 8, I_SQ = 8 * 8, I_GU = 8 * (2 * DFF / 128), I_DN = (DFF / 128) * 8;
constexpr int W_EARLY = I_IN + I_KV, W_ITEMS = W_EARLY + I_A + I_B + 3 * I_SQ + I_GU + I_DN;
__device__ __forceinline__ void weight_item(int q, const float* w_in, const float* w_a, const float* w_b, const float* w_out, const float* w_xq, const float* w_xo, const float* w_xkv, const float* w_gate, const float* w_up,
                                            const float* w_down, const float* norm_cross, const float* norm_ffn, bf16* WIN, bf16* WAB, bf16* WOUT, bf16* WXQ, bf16* WXO, bf16* WXKV, bf16* WGU, bf16* WDN, LAS unsigned char* lds, int tid) {
    if (q < I_IN) { p0_tile128(w_in, w_in, INC, INC, 1, WIN, 1024, 0, lds, q, tid); return; } q -= I_IN;
    if (q < I_KV) { p0_tile128(w_xkv, w_xkv, 2048, 2048, 0, WXKV, 1024, 0, lds, q, tid); return; } q -= I_KV;
    if (q < I_A) { p0_tile128(w_a, w_a, 1024, 1024, 0, WAB, 1536, 0, lds, q, tid); return; } q -= I_A;
    if (q < I_B) { p0_tile128(w_b, w_b, 1024, 1024, 0, WAB, 1536, 512, lds, q, tid); return; } q -= I_B;
    if (q < I_SQ) { p0_tile128(w_out, w_out, 1024, 1024, 0, WOUT, 1024, 0, lds, q, tid); return; } q -= I_SQ;
    if (q < I_SQ) { p0_tile128(w_xq, w_xq, 1024, 1024, 0, WXQ, 1024, 0, lds, q, tid, norm_cross); return; } q -= I_SQ;
    if (q < I_SQ) { p0_tile128(w_xo, w_xo, 1024, 1024, 0, WXO, 1024, 0, lds, q, tid); return; } q -= I_SQ;
    if (q < I_GU) { p0_tile128(w_gate, w_up, DFF, 2 * DFF, 2, WGU, 1024, 0, lds, q, tid, norm_ffn); return; } q -= I_GU;
    p0_tile128(w_down, w_down, 1024, 1024, 0, WDN, DFF, 0, lds, q, tid);
}
__device__ __forceinline__ void rms_row_to_bf16(const float* xrow, const float* gain, bf16* orow, int lane) {
    const GAS f32x4* xr = (const GAS f32x4*)xrow + lane; const GAS f32x4* gr = (const GAS f32x4*)gain + lane;
    f32x4 v[4]; float s = 0.f;
#pragma unroll
    for (int j = 0; j < 4; ++j) { v[j] = xr[64 * j]; s += (v[j].x * v[j].x + v[j].y * v[j].y) + (v[j].z * v[j].z + v[j].w * v[j].w); }
    const float rstd = 1.f / sqrtf(wave_sum(s) * (1.f / DM) + EPS);
    GAS unsigned long long* o8 = (GAS unsigned long long*)orow + lane;
#pragma unroll
    for (int j = 0; j < 4; ++j) { const f32x4 g = gr[64 * j]; o8[64 * j] = (unsigned long long)pk2(v[j].x * rstd * g.x, v[j].y * rstd * g.y) | ((unsigned long long)pk2(v[j].z * rstd * g.z, v[j].w * rstd * g.w) << 32); }
}
template <int NR> __device__ __forceinline__ void rms_rows_to_bf16(const float* xbase, const float* gain, bf16* obase, int m0, int stride, int lane) {
    f32x4 v[NR][4]; float s[NR];
#pragma unroll
    for (int q = 0; q < NR; ++q) { const GAS f32x4* xr = (const GAS f32x4*)(xbase + (size_t)(m0 + q * stride) * DM) + lane;
#pragma unroll
        for (int j = 0; j < 4; ++j) v[q][j] = __builtin_nontemporal_load(xr + 64 * j); }
#pragma unroll
    for (int q = 0; q < NR; ++q) { float a = 0.f;
#pragma unroll
        for (int j = 0; j < 4; ++j) a += (v[q][j].x * v[q][j].x + v[q][j].y * v[q][j].y) + (v[q][j].z * v[q][j].z + v[q][j].w * v[q][j].w);
        s[q] = 1.f / sqrtf(wave_sum(a) * (1.f / DM) + EPS); }
    const GAS f32x4* gr = (const GAS f32x4*)gain + lane;
#pragma unroll
    for (int j = 0; j < 4; ++j) { const f32x4 g = gr[64 * j];
#pragma unroll
        for (int q = 0; q < NR; ++q) { GAS unsigned long long* o8 = (GAS unsigned long long*)(obase + (size_t)(m0 + q * stride) * DM) + lane;
            o8[64 * j] = (unsigned long long)pk2(v[q][j].x * s[q] * g.x, v[q][j].y * s[q] * g.y) | ((unsigned long long)pk2(v[q][j].z * s[q] * g.z, v[q][j].w * s[q] * g.w) << 32); } }
}
__device__ __forceinline__ void rope_cs(int pos, int f, int dh, float& c, float& s) {
    const float inv = exp2f(-((float)(2 * f) / (float)dh) * 13.287712379549449f);
    const float ang = (float)pos * inv;
    const double x = (double)ang, n = __builtin_rint(x * 0.15915494309189535);
    double r = __builtin_fma(-n, 6.283185307179586, x); r = __builtin_fma(-n, 2.4492935982947064e-16, r);
    const double r2 = r * r; double ts = r, ss = r, tc = 1.0, sc = 1.0;
#pragma unroll
    for (int k = 1; k <= 15; ++k) { tc *= r2 * (-1.0 / (double)((2 * k - 1) * (2 * k))); sc += tc; ts *= r2 * (-1.0 / (double)((2 * k) * (2 * k + 1))); ss += ts; }
    c = (float)sc; s = (float)ss;
}

typedef float f32x16 __attribute__((ext_vector_type(16)));
typedef short s16x4 __attribute__((ext_vector_type(4)));
#define MFMA32(a, b, c) __builtin_amdgcn_mfma_f32_32x32x16_bf16((a), (b), (c), 0, 0, 0)
__device__ __forceinline__ int crow(int r, int hi) { return (r & 3) + 8 * (r >> 2) + 4 * hi; }
__device__ __forceinline__ bf16x8 ld16(const bf16* p) { return *(const bf16x8*)p; }
__device__ __forceinline__ float bf2f(short b) { return __builtin_bit_cast(float, (unsigned)(unsigned short)b << 16); }
template <int BASE> __device__ __forceinline__ bf16x8 pack8(const f32x16& p) {
    v4u w; w.x = pk2(p[BASE], p[BASE + 1]); w.y = pk2(p[BASE + 2], p[BASE + 3]); w.z = pk2(p[BASE + 4], p[BASE + 5]); w.w = pk2(p[BASE + 6], p[BASE + 7]);
    return __builtin_bit_cast(bf16x8, w);
}
__device__ __forceinline__ f32x16 splat16(float v) { f32x16 r;
#pragma unroll
    for (int i = 0; i < 16; ++i) r[i] = v;
    return r; }
__device__ __forceinline__ int vrow(int r) { return 16 * ((r >> 2) & 1) + (r & 3) + 4 * (r >> 3); }
#define GLDS16(gptr, ldsptr) __builtin_amdgcn_global_load_lds((const unsigned*)(gptr), (LAS unsigned*)(ldsptr), 16, 0, 0)
#define GLDS16NT(gptr, ldsptr) __builtin_amdgcn_global_load_lds((const unsigned*)(gptr), (LAS unsigned*)(ldsptr), 16, 0, 2)
struct SmState { float m, l; f32x16 negm; };
constexpr float SM_THR = 8.0f;
template <int NS, int NO, int KRB>
__device__ __forceinline__ void attn_half_sw(const LAS unsigned char* kl, const LAS unsigned char* vl, const bf16x8 (&qf)[NS], SmState& S, f32x16 (&o)[NO], int kbh, bool first, int r, int hh) {
    f32x16 p0;
    const int rv = vrow(r), v7 = rv & 7, x7 = v7;
    const LAS unsigned char* ka = kl + (32 * kbh + rv) * KRB;
#pragma unroll
    for (int s = 0; s < NS; ++s) { const int co = ((2 * s + hh) ^ x7) << 4; const bf16x8 a0 = *(const LAS bf16x8*)(ka + co);
        if (s == 0) p0 = MFMA32(a0, qf[0], S.negm); else p0 = MFMA32(a0, qf[s], p0); }
    float ta = fmaxf(fmaxf(p0[0], p0[1]), p0[2]), tb = fmaxf(fmaxf(p0[3], p0[4]), p0[5]);
    ta = fmaxf(fmaxf(ta, p0[6]), p0[7]); tb = fmaxf(fmaxf(tb, p0[8]), p0[9]); ta = fmaxf(fmaxf(ta, p0[10]), p0[11]); tb = fmaxf(fmaxf(tb, p0[12]), p0[13]); ta = fmaxf(fmaxf(ta, p0[14]), p0[15]);
    float tm = fmaxf(ta, tb);
    { const auto rr = __builtin_amdgcn_permlane32_swap(__float_as_uint(tm), __float_as_uint(tm), false, false); tm = fmaxf(__uint_as_float(rr[0]), __uint_as_float(rr[1])); }
    if (first || __any(tm > SM_THR)) {
        float dl = first ? tm : fmaxf(tm, 0.f); if (dl == NEG_INF) dl = 0.f;
        S.m += dl;
#pragma unroll
        for (int rg = 0; rg < 16; ++rg) { p0[rg] -= dl; S.negm[rg] = -S.m; }
        if (!first) { const float f = __builtin_amdgcn_exp2f(-dl); S.l *= f;
#pragma unroll
            for (int db = 0; db < NO; ++db) o[db] = o[db] * f; }
    }
    float sum = 0.f;
#pragma unroll
    for (int rg = 0; rg < 16; ++rg) { p0[rg] = __builtin_amdgcn_exp2f(p0[rg]); sum += p0[rg]; }
    S.l += sum;
    v4u w0, w1;
    w0.x = pk2(p0[0], p0[1]); w0.y = pk2(p0[2], p0[3]); w0.z = pk2(p0[4], p0[5]); w0.w = pk2(p0[6], p0[7]);
    w1.x = pk2(p0[8], p0[9]); w1.y = pk2(p0[10], p0[11]); w1.z = pk2(p0[12], p0[13]); w1.w = pk2(p0[14], p0[15]);
    const bf16x8 pb0 = __builtin_bit_cast(bf16x8, w0), pb1 = __builtin_bit_cast(bf16x8, w1);
#pragma unroll
    for (int db = 0; db < NO; ++db) { const LAS unsigned char* vr = vl + (32 * db + rv) * 128;
#define VFRAG(ks) (*(const LAS bf16x8*)(vr + (((4 * kbh + 2 * hh + (ks)) ^ v7) << 4)))
        o[db] = MFMA32(VFRAG(0), pb0, o[db]); o[db] = MFMA32(VFRAG(1), pb1, o[db]);
#undef VFRAG
    }
}
template <int NS, int NO, int KRB, int MASK>
__device__ __forceinline__ void attn_tile_bf(const LAS unsigned char* kl, const LAS unsigned char* vl, const bf16x8 (&qf)[NS], float& m, float& l, f32x16 (&o)[NO], int qd, bool lane_on, int r, int hh) {
    f32x16 p0 = splat16(0.f), p1 = splat16(0.f);
    const int rv = vrow(r), v7 = rv & 7;
    const int x7 = v7;
    const LAS unsigned char* ka = kl + rv * KRB;
#pragma unroll
    for (int s = 0; s < NS; ++s) { const int co = ((2 * s + hh) ^ x7) << 4; const bf16x8 a0 = *(const LAS bf16x8*)(ka + co), a1 = *(const LAS bf16x8*)(ka + 32 * KRB + co); p0 = MFMA32(a0, qf[s], p0); p1 = MFMA32(a1, qf[s], p1); }
    if (MASK == 1) {
#pragma unroll
        for (int rg = 0; rg < 16; ++rg) { const int kv = 16 * hh + rg; if (kv > qd) p0[rg] = NEG_INF; if (kv + 32 > qd) p1[rg] = NEG_INF; }
    }
    float ta = fmaxf(fmaxf(p0[0], p0[1]), p1[0]), tb = fmaxf(fmaxf(p0[2], p0[3]), p1[1]); ta = fmaxf(fmaxf(ta, p1[2]), p1[3]);
#pragma unroll
    for (int rg = 4; rg < 16; rg += 4) { ta = fmaxf(fmaxf(ta, p0[rg]), p0[rg + 1]); tb = fmaxf(fmaxf(tb, p0[rg + 2]), p0[rg + 3]); ta = fmaxf(fmaxf(ta, p1[rg]), p1[rg + 1]); tb = fmaxf(fmaxf(tb, p1[rg + 2]), p1[rg + 3]); }
    float tm = fmaxf(ta, tb);
    { const auto rr = __builtin_amdgcn_permlane32_swap(__float_as_uint(tm), __float_as_uint(tm), false, false); tm = fmaxf(__uint_as_float(rr[0]), __uint_as_float(rr[1])); }
    if (MASK == 2) tm = lane_on ? tm : NEG_INF;
    const float mn = (tm > m + SM_THR) ? tm : m, ms = (mn == NEG_INF) ? 0.f : mn;
    const float f = __builtin_amdgcn_exp2f(m - ms);
    m = mn;
    float sum = 0.f;
#pragma unroll
    for (int rg = 0; rg < 16; ++rg) { p0[rg] = __builtin_amdgcn_exp2f(p0[rg] - ms); p1[rg] = __builtin_amdgcn_exp2f(p1[rg] - ms); sum += p0[rg] + p1[rg]; }
    v4u w0, w1, w2, w3;
    w0.x = pk2(p0[0], p0[1]); w0.y = pk2(p0[2], p0[3]); w0.z = pk2(p0[4], p0[5]); w0.w = pk2(p0[6], p0[7]);
    w1.x = pk2(p0[8], p0[9]); w1.y = pk2(p0[10], p0[11]); w1.z = pk2(p0[12], p0[13]); w1.w = pk2(p0[14], p0[15]);
    w2.x = pk2(p1[0], p1[1]); w2.y = pk2(p1[2], p1[3]); w2.z = pk2(p1[4], p1[5]); w2.w = pk2(p1[6], p1[7]);
    w3.x = pk2(p1[8], p1[9]); w3.y = pk2(p1[10], p1[11]); w3.z = pk2(p1[12], p1[13]); w3.w = pk2(p1[14], p1[15]);
    if (MASK == 2) { const unsigned km = lane_on ? 0xffffffffu : 0u; w0 = w0 & km; w1 = w1 & km; w2 = w2 & km; w3 = w3 & km; sum = lane_on ? sum : 0.f; }
    l = l * f + sum;
    const bf16x8 pb0 = __builtin_bit_cast(bf16x8, w0), pb1 = __builtin_bit_cast(bf16x8, w1), pb2 = __builtin_bit_cast(bf16x8, w2), pb3 = __builtin_bit_cast(bf16x8, w3);
#pragma unroll
    for (int db = 0; db < NO; ++db) { const LAS unsigned char* vr = vl + (32 * db + rv) * 128; o[db] = o[db] * f;
#define VFRAG(i) (*(const LAS bf16x8*)(vr + (((4 * ((i) >> 1) + 2 * hh + ((i) & 1)) ^ v7) << 4)))
        o[db] = MFMA32(VFRAG(0), pb0, o[db]); o[db] = MFMA32(VFRAG(1), pb1, o[db]); o[db] = MFMA32(VFRAG(2), pb2, o[db]); o[db] = MFMA32(VFRAG(3), pb3, o[db]);
#undef VFRAG
    }
}
template <int NS, int NO, int KRB>
__device__ __forceinline__ void attn_tile_dr(const LAS unsigned char* kl, const LAS unsigned char* vl, const bf16x8 (&qf)[NS], float& m, float& l, f32x16& negm, f32x16 (&o)[NO], bool first, bool lane_on, int r, int hh) {
    f32x16 p0, p1;
    const int rv = vrow(r), v7 = rv & 7;
    const LAS unsigned char* ka = kl + rv * KRB;
#pragma unroll
    for (int s = 0; s < NS; ++s) { const int co = ((2 * s + hh) ^ v7) << 4; const bf16x8 a0 = *(const LAS bf16x8*)(ka + co), a1 = *(const LAS bf16x8*)(ka + 32 * KRB + co);
        if (s == 0) { p0 = MFMA32(a0, qf[0], negm); p1 = MFMA32(a1, qf[0], negm); } else { p0 = MFMA32(a0, qf[s], p0); p1 = MFMA32(a1, qf[s], p1); } }
    float ta = fmaxf(fmaxf(p0[0], p0[1]), p1[0]), tb = fmaxf(fmaxf(p0[2], p0[3]), p1[1]); ta = fmaxf(fmaxf(ta, p1[2]), p1[3]);
#pragma unroll
    for (int rg = 4; rg < 16; rg += 4) { ta = fmaxf(fmaxf(ta, p0[rg]), p0[rg + 1]); tb = fmaxf(fmaxf(tb, p0[rg + 2]), p0[rg + 3]); ta = fmaxf(fmaxf(ta, p1[rg]), p1[rg + 1]); tb = fmaxf(fmaxf(tb, p1[rg + 2]), p1[rg + 3]); }
    float tm = fmaxf(ta, tb);
    { const auto rr = __builtin_amdgcn_permlane32_swap(__float_as_uint(tm), __float_as_uint(tm), false, false); tm = fmaxf(__uint_as_float(rr[0]), __uint_as_float(rr[1])); }
    tm = lane_on ? tm : NEG_INF;
    if (first || __any(tm > SM_THR)) {
        float dl = first ? tm : fmaxf(tm, 0.f); if (dl == NEG_INF) dl = 0.f;
        m += dl;
#pragma unroll
        for (int rg = 0; rg < 16; ++rg) { p0[rg] -= dl; p1[rg] -= dl; negm[rg] = -m; }
        if (!first) { const float f = __builtin_amdgcn_exp2f(-dl); l *= f;
#pragma unroll
            for (int db = 0; db < NO; ++db) o[db] = o[db] * f; }
    }
    float sum = 0.f;
#pragma unroll
    for (int rg = 0; rg < 16; ++rg) { p0[rg] = __builtin_amdgcn_exp2f(p0[rg]); p1[rg] = __builtin_amdgcn_exp2f(p1[rg]); sum += p0[rg] + p1[rg]; }
    v4u w0, w1, w2, w3;
    w0.x = pk2(p0[0], p0[1]); w0.y = pk2(p0[2], p0[3]); w0.z = pk2(p0[4], p0[5]); w0.w = pk2(p0[6], p0[7]);
    w1.x = pk2(p0[8], p0[9]); w1.y = pk2(p0[10], p0[11]); w1.z = pk2(p0[12], p0[13]); w1.w = pk2(p0[14], p0[15]);
    w2.x = pk2(p1[0], p1[1]); w2.y = pk2(p1[2], p1[3]); w2.z = pk2(p1[4], p1[5]); w2.w = pk2(p1[6], p1[7]);
    w3.x = pk2(p1[8], p1[9]); w3.y = pk2(p1[10], p1[11]); w3.z = pk2(p1[12], p1[13]); w3.w = pk2(p1[14], p1[15]);
    { const unsigned km = lane_on ? 0xffffffffu : 0u; w0 = w0 & km; w1 = w1 & km; w2 = w2 & km; w3 = w3 & km; sum = lane_on ? sum : 0.f; }
    l += sum;
    const bf16x8 pb0 = __builtin_bit_cast(bf16x8, w0), pb1 = __builtin_bit_cast(bf16x8, w1), pb2 = __builtin_bit_cast(bf16x8, w2), pb3 = __builtin_bit_cast(bf16x8, w3);
#pragma unroll
    for (int db = 0; db < NO; ++db) { const LAS unsigned char* vr = vl + (32 * db + rv) * 128;
#define VFRAG(i) (*(const LAS bf16x8*)(vr + (((4 * ((i) >> 1) + 2 * hh + ((i) & 1)) ^ v7) << 4)))
        o[db] = MFMA32(VFRAG(0), pb0, o[db]); o[db] = MFMA32(VFRAG(1), pb1, o[db]); o[db] = MFMA32(VFRAG(2), pb2, o[db]); o[db] = MFMA32(VFRAG(3), pb3, o[db]);
#undef VFRAG
    }
}
constexpr int MD_STG = 16384;
__device__ __forceinline__ bf16* po_ptr(bf16* PO0, bf16* YAB, int b, int h, int q, int slot) {
    return slot == 0 ? PO0 + ((size_t)((b * 8 + h) * SEQ + q)) * 64 : YAB + ((size_t)((b * 16 + (q >> 8)) * 24 + 8)) * 16384 + (size_t)((((slot - 1) * 8 + h) * 256 + (q & 255)) * 64);
}
__device__ __forceinline__ void moba_select_item(LAS unsigned char* lds, const bf16* YAB, const float* KMEAN, unsigned short* LIST, unsigned* CNT, int b, int h, int qb, int w, int lane) {
    const int r = lane & 31, hh = lane >> 5, q = qb * 256 + 32 * w + r, bh = b * 8 + h;
    const bf16* Qp = YAB + pg8::yab_idx((size_t)b * SEQ + q, h * 64);
    bf16x8 qf[4];
#pragma unroll
    for (int s = 0; s < 4; ++s) qf[s] = ld16(Qp + 16 * s + 8 * hh);
    LAS float* kml = (LAS float*)lds;
    { const int e = 2 * (w * 64 + lane); const unsigned long long kv = *(const unsigned long long*)(KMEAN + (size_t)(b * 16 + (e >> 6)) * 512 + h * 64 + (e & 63)); *(LAS unsigned long long*)(kml + e) = kv; }
    __syncthreads();
    const LAS float* km = kml + 8 * hh;
    float v1 = NEG_INF, v2 = NEG_INF, v3 = NEG_INF; int i1 = -1, i2 = -1, i3 = -1;
    for (int j = 0; j < qb; ++j) {
        float dot = 0.f;
#pragma unroll
        for (int s = 0; s < 4; ++s) { const f32x4 ka = *(const LAS f32x4*)(km + j * 64 + 16 * s), kb = *(const LAS f32x4*)(km + j * 64 + 16 * s + 4);
            dot += bf2f(qf[s][0]) * ka[0] + bf2f(qf[s][1]) * ka[1] + bf2f(qf[s][2]) * ka[2] + bf2f(qf[s][3]) * ka[3] + bf2f(qf[s][4]) * kb[0] + bf2f(qf[s][5]) * kb[1] + bf2f(qf[s][6]) * kb[2] + bf2f(qf[s][7]) * kb[3]; }
        dot += __shfl_xor(dot, 32);
        if (dot > v1) { v3 = v2; i3 = i2; v2 = v1; i2 = i1; v1 = dot; i1 = j; } else if (dot > v2) { v3 = v2; i3 = i2; v2 = dot; i2 = j; } else if (dot > v3) { v3 = dot; i3 = j; }
    }
    unsigned mycnt = 0u;
    for (int j = 0; j < qb; ++j) { const unsigned long long mask = __ballot((hh == 0) && (i1 == j || i2 == j || i3 == j)); if (lane == j) mycnt = (unsigned)__popcll(mask); }
    unsigned mybase = 0u;
    if (mycnt != 0u) mybase = atomicAdd(CNT + bh * 16 + lane, mycnt);
    for (int j = 0; j < qb; ++j) {
        const bool sel = (hh == 0) && (i1 == j || i2 == j || i3 == j);
        const unsigned long long mask = __ballot(sel);
        const unsigned base = (unsigned)__builtin_amdgcn_readlane((int)mybase, j);
        const unsigned pos = base + __builtin_amdgcn_mbcnt_hi((unsigned)(mask >> 32), __builtin_amdgcn_mbcnt_lo((unsigned)mask, 0u));
        const unsigned slot = (i1 == j) ? 0u : (i2 == j) ? 1u : 2u;
        if (sel) LIST[(size_t)(bh * 16 + j) * 4096 + pos] = (unsigned short)((unsigned)q | (slot << 12));
    }
    __syncthreads();
}
__device__ __forceinline__ void moba_past_unit(LAS unsigned char* lds, bf16* YAB, const bf16* AK, const bf16* AVT, const unsigned short* LIST, const unsigned* CNT, bf16* PO0, float* PML, int b, int h, int jA, int jB, int w, int lane) {
    const int r = lane & 31, hh = lane >> 5, bh = b * 8 + h;
    const int srow = 8 * w + (lane >> 3), sch = (lane & 7) ^ (lane >> 3);
    LAS unsigned char* kd = lds + w * 1024;
#pragma unroll
    for (int u = 0; u < 2; ++u) { const int j = u ? jB : jA; if (j >= 0) {
        const bf16* kg = AK + ((size_t)bh * SEQ + j * 256 + srow) * 64 + sch * 8;
        const bf16* vg = AVT + ((size_t)bh * 64 * 64 + (size_t)(4 * j) * 64 + srow) * 64 + sch * 8;
#pragma unroll
        for (int t = 0; t < 4; ++t) { GLDS16(kg + (size_t)t * 4096, kd + (4 * u + t) * MD_STG); GLDS16(vg + (size_t)t * 4096, kd + (4 * u + t) * MD_STG + 8192); } } }
    const unsigned nA = (unsigned)__builtin_amdgcn_readfirstlane((int)CNT[bh * 16 + jA]), nB = jB >= 0 ? (unsigned)__builtin_amdgcn_readfirstlane((int)CNT[bh * 16 + jB]) : 0u;
    const unsigned short* lstA = LIST + (size_t)(bh * 16 + jA) * 4096; const unsigned short* lstB = LIST + (size_t)(bh * 16 + (jB >= 0 ? jB : jA)) * 4096;
    asm volatile("s_waitcnt vmcnt(0) lgkmcnt(0)" ::: "memory"); __builtin_amdgcn_s_barrier(); asm volatile("" ::: "memory");
    const int nbA = (int)((nA + 31u) >> 5), nb = nbA + (int)((nB + 31u) >> 5);
    if (w < nb) {
#define MP_ENT(dst, bidx) do { const int bb_ = (bidx); const bool inA_ = bb_ < nbA; const unsigned n_ = inA_ ? nA : nB; const unsigned e_ = (unsigned)((inA_ ? bb_ : bb_ - nbA) * 32 + r); \
        const unsigned short* p_ = (inA_ ? lstA : lstB) + ((e_ < n_) ? e_ : 0u); asm volatile("global_load_ushort %0, %1, off" : "=v"(dst) : "v"(p_) : "memory"); } while (0)
#define MP_Q(dst, ent_) do { const bf16* p_ = YAB + pg8::yab_idx((size_t)b * SEQ + ((ent_) & 4095u), h * 64) + 8 * hh; \
        _Pragma("unroll") for (int s_ = 0; s_ < 4; ++s_) { const bf16* ps_ = p_ + 16 * s_; asm volatile("global_load_dwordx4 %0, %1, off" : "=v"(dst[s_]) : "v"(ps_) : "memory"); } } while (0)
        unsigned entc, entn, entnn; bf16x8 qf[4], qn[4];
        MP_ENT(entc, w); MP_ENT(entn, w + 8);
        asm volatile("s_waitcnt vmcnt(0)" : "+v"(entc), "+v"(entn) :: "memory");
        MP_Q(qf, entc);
        asm volatile("s_waitcnt vmcnt(0)" : "+v"(qf[0]), "+v"(qf[1]), "+v"(qf[2]), "+v"(qf[3]) :: "memory");
        for (int bi = w; bi < nb; bi += 8) {
            MP_Q(qn, entn); MP_ENT(entnn, bi + 16);
            const bool inA = bi < nbA; const bool on = (unsigned)((inA ? bi : bi - nbA) * 32 + r) < (inA ? nA : nB);
            const LAS unsigned char* blk = lds + (inA ? 0 : 4 * MD_STG);
            const int q = (int)(entc & 4095u), slot = (int)((entc >> 12) & 3u);
            float m_run = 0.f, l_run = 0.f; f32x16 negm = splat16(0.f), o[2]; o[0] = splat16(0.f); o[1] = splat16(0.f);
#pragma unroll 1
            for (int t = 0; t < 4; ++t) attn_tile_dr<4, 2, 128>(blk + t * MD_STG, blk + t * MD_STG + 8192, qf, m_run, l_run, negm, o, t == 0, on, r, hh);
            const float l_tot = l_run + __shfl_xor(l_run, 32), inv = 1.0f / l_tot;
            if (on) {
                bf16* po = po_ptr(PO0, YAB, b, h, q, slot) + 16 * hh;
#pragma unroll
                for (int db = 0; db < 2; ++db) { const f32x16 ov = o[db] * inv; *(bf16x8*)(po + 32 * db) = pack8<0>(ov); *(bf16x8*)(po + 32 * db + 8) = pack8<8>(ov); }
                if (hh == 0) *(pg8::f32x2_t*)(PML + ((size_t)(bh * SEQ + q) * 3 + slot) * 2) = (pg8::f32x2_t){m_run, l_tot};
            }
            asm volatile("s_waitcnt vmcnt(5)" : "+v"(qn[0]), "+v"(qn[1]), "+v"(qn[2]), "+v"(qn[3]), "+v"(entnn) :: "memory");
#pragma unroll
            for (int s_ = 0; s_ < 4; ++s_) qf[s_] = qn[s_];
            entc = entn; entn = entnn;
        }
#undef MP_ENT
#undef MP_Q
    }
    asm volatile("s_waitcnt vmcnt(0) lgkmcnt(0)" ::: "memory"); __builtin_amdgcn_s_barrier(); asm volatile("" ::: "memory");
}
struct OwnIn { bf16x8 qf[4]; float ms[3], ls[3]; bf16x8 pp[3][4]; };
__device__ __forceinline__ void moba_own_load(OwnIn& I, bf16* YAB, bf16* PO0, const float* PML, int b, int h, int qb, int g, int lane) {
    const int r = lane & 31, hh = lane >> 5, q = qb * 256 + 32 * g + r, bh = b * 8 + h;
    const bf16* Qp = YAB + pg8::yab_idx((size_t)b * SEQ + q, h * 64);
#pragma unroll
    for (int s = 0; s < 4; ++s) I.qf[s] = ld16(Qp + 16 * s + 8 * hh);
    const int ns = qb < 3 ? qb : 3;
#pragma unroll
    for (int s = 0; s < 3; ++s) { I.ms[s] = NEG_INF; I.ls[s] = 0.f;
#pragma unroll
        for (int k = 0; k < 4; ++k) I.pp[s][k] = (bf16x8){0, 0, 0, 0, 0, 0, 0, 0};
        if (s < ns) { const pg8::f32x2_t v = *(const pg8::f32x2_t*)(PML + ((size_t)(bh * SEQ + q) * 3 + s) * 2); I.ms[s] = v[0]; I.ls[s] = v[1];
            const bf16* po = po_ptr(PO0, YAB, b, h, q, s) + 16 * hh;
#pragma unroll
            for (int db = 0; db < 2; ++db) { I.pp[s][2 * db] = ld16(po + 32 * db); I.pp[s][2 * db + 1] = ld16(po + 32 * db + 8); } } }
}
__device__ __forceinline__ void moba_own_part(const OwnIn& I, const LAS unsigned char* blk, bf16* YAB, int b, int h, int qb, int g, int lane) {
    const int r = lane & 31, hh = lane >> 5, qrel = 32 * g + r, q = qb * 256 + qrel;
    bf16* Qp = YAB + pg8::yab_idx((size_t)b * SEQ + q, h * 64);
    float m_run = NEG_INF, l_run = 0.f; f32x16 o[2]; o[0] = splat16(0.f); o[1] = splat16(0.f);
#pragma unroll 1
    for (int t = 0; t <= (g >> 1); ++t) attn_tile_bf<4, 2, 128, 1>(blk + t * MD_STG, blk + t * MD_STG + 8192, I.qf, m_run, l_run, o, qrel - 64 * t, true, r, hh);
    const float l_own = l_run + __shfl_xor(l_run, 32);
    const float M = fmaxf(fmaxf(m_run, I.ms[0]), fmaxf(I.ms[1], I.ms[2]));
    const float wo = __builtin_amdgcn_exp2f(m_run - M);
    float L = l_own * wo; o[0] = o[0] * wo; o[1] = o[1] * wo;
#pragma unroll
    for (int s = 0; s < 3; ++s) { const float wsl = I.ls[s] * __builtin_amdgcn_exp2f(I.ms[s] - M); L += wsl;
#pragma unroll
        for (int db = 0; db < 2; ++db)
#pragma unroll
            for (int i = 0; i < 8; ++i) { o[db][i] += bf2f(I.pp[s][2 * db][i]) * wsl; o[db][8 + i] += bf2f(I.pp[s][2 * db + 1][i]) * wsl; } }
    const float inv = 1.0f / L;
#pragma unroll
    for (int db = 0; db < 2; ++db) { const f32x16 ov = o[db] * inv; *(bf16x8*)(Qp + 32 * db + 16 * hh) = pack8<0>(ov); *(bf16x8*)(Qp + 32 * db + 16 * hh + 8) = pack8<8>(ov); }
}
__device__ __forceinline__ void moba_own_pair(LAS unsigned char* lds, bf16* YAB, const bf16* AK, const bf16* AVT, bf16* PO0, const float* PML, int b, int h, int qbA, int qbB, int w, int lane) {
    const int bh = b * 8 + h, srow = 8 * w + (lane >> 3), sch = (lane & 7) ^ (lane >> 3);
    LAS unsigned char* kd = lds + w * 1024;
#pragma unroll
    for (int u = 0; u < 2; ++u) { const int qb = u ? qbB : qbA;
        const bf16* kg = AK + ((size_t)bh * SEQ + qb * 256 + srow) * 64 + sch * 8;
        const bf16* vg = AVT + ((size_t)bh * 64 * 64 + (size_t)(4 * qb) * 64 + srow) * 64 + sch * 8;
#pragma unroll
        for (int t = 0; t < 4; ++t) { GLDS16(kg + (size_t)t * 4096, kd + (4 * u + t) * MD_STG); GLDS16(vg + (size_t)t * 4096, kd + (4 * u + t) * MD_STG + 8192); } }
    OwnIn I; moba_own_load(I, YAB, PO0, PML, b, h, qbA, w, lane);
    asm volatile("s_waitcnt vmcnt(0) lgkmcnt(0)" ::: "memory"); __builtin_amdgcn_s_barrier(); asm volatile("" ::: "memory");
    moba_own_part(I, lds, YAB, b, h, qbA, w, lane);
    moba_own_load(I, YAB, PO0, PML, b, h, qbB, 7 - w, lane);
    moba_own_part(I, lds + 4 * MD_STG, YAB, b, h, qbB, 7 - w, lane);
    asm volatile("s_waitcnt vmcnt(0) lgkmcnt(0)" ::: "memory"); __builtin_amdgcn_s_barrier(); asm volatile("" ::: "memory");
}

constexpr int XA_STG = 65536;
__device__ __forceinline__ void xattn_units(LAS unsigned char* lds, const bf16* QX, const bf16* KX, const bf16* VXT, bf16* OX, int u0, int nu, int w, int lane) {
    const int r = lane & 31, hh = lane >> 5, qg = w >> 1, dh = w & 1;
    const int kr0 = 8 * w + (lane >> 5), vr0 = 32 * w + (lane >> 3);
    LAS unsigned char* dk = lds + w * 4096; LAS unsigned char* dv = lds + 32768 + w * 4096;
#define XA_ISSUE(T) do { const int u_ = u0 + ((T) >> 2), kt_ = (T) & 3, bh_ = u_ >> 5; const int sg_ = ((T) & 1) * XA_STG; \
        const bf16* kb_ = KX + ((size_t)(bh_ * 256 + 64 * kt_)) * 256; const bf16* vb_ = VXT + ((size_t)(bh_ * 4 + kt_) * 256) * 64; \
        _Pragma("unroll") for (int i_ = 0; i_ < 4; ++i_) { const int row_ = kr0 + 2 * i_; GLDS16(kb_ + (size_t)row_ * 256 + (((lane & 31) ^ (row_ & 7)) << 3), dk + sg_ + i_ * 1024); } \
        _Pragma("unroll") for (int i_ = 0; i_ < 4; ++i_) { const int row_ = vr0 + 8 * i_; GLDS16(vb_ + (size_t)row_ * 64 + (((lane & 7) ^ (lane >> 3)) << 3), dv + sg_ + i_ * 1024); } } while (0)
    const int NTT = 4 * nu;
    XA_ISSUE(0);
    bf16x8 qf[16]; SmState S; f32x16 o[4];
    for (int T = 0; T < NTT; ++T) {
        const int t = T & 3, u = u0 + (T >> 2), bh = u >> 5;
        const size_t qrow = (size_t)(bh >> 2) * SEQ + (u & 31) * 128 + 32 * qg + r;
        if (t == 0) {
#pragma unroll
            for (int s = 0; s < 16; ++s) qf[s] = ld16(QX + qrow * 1024 + (bh & 3) * 256 + 16 * s + 8 * hh);
            S.m = 0.f; S.l = 0.f; S.negm = splat16(0.f);
#pragma unroll
            for (int db = 0; db < 4; ++db) o[db] = splat16(0.f);
        }
        asm volatile("s_waitcnt vmcnt(0) lgkmcnt(0)" ::: "memory"); __builtin_amdgcn_s_barrier(); asm volatile("" ::: "memory");
        if (T + 1 < NTT) XA_ISSUE(T + 1);
        const LAS unsigned char* sb = lds + (T & 1) * XA_STG;
        attn_half_sw<16, 4, 512>(sb, sb + 32768 + dh * 16384, qf, S, o, 0, t == 0, r, hh);
        attn_half_sw<16, 4, 512>(sb, sb + 32768 + dh * 16384, qf, S, o, 1, false, r, hh);
        if (t == 3) {
            const float inv = 1.0f / (S.l + __shfl_xor(S.l, 32));
            bf16* op = OX + qrow * 1024 + (bh & 3) * 256 + 128 * dh + 16 * hh;
#pragma unroll
            for (int db = 0; db < 4; ++db) { const f32x16 ov = o[db] * inv; *(bf16x8*)(op + 32 * db) = pack8<0>(ov); *(bf16x8*)(op + 32 * db + 8) = pack8<8>(ov); }
        }
    }
#undef XA_ISSUE
    asm volatile("s_waitcnt vmcnt(0) lgkmcnt(0)" ::: "memory"); __builtin_amdgcn_s_barrier(); asm volatile("" ::: "memory");
}

constexpr int SC_STG = 32768;
__device__ __forceinline__ void scan_unit(LAS unsigned char* lds, const bf16* RKT, const bf16* RVT, bf16* ST, int b, int hr, int eh, int w, int lane) {
    const int es = 4 * eh + (w & 3), dg = w >> 2;
    const int r = lane & 31, hh = lane >> 5; const float dec = __builtin_amdgcn_exp2f(128.0f * pg8::lg2gamma(hr));
    const int tq = (lane & 15) >> 2, tp = lane & 3, tg = (lane >> 4) & 1;
    int aoff[2][2];
#pragma unroll
    for (int dbl = 0; dbl < 2; ++dbl)
#pragma unroll
        for (int k2 = 0; k2 < 2; ++k2) aoff[dbl][k2] = 256 * (8 * hh + 4 * k2 + tq) + 16 * ((4 * (2 * dg + dbl) + tg + 2 * (tp & 1)) ^ ((tq << 2) | (2 * hh + k2))) + 8 * (tp >> 1);
    f32x16 st[2];
#pragma unroll
    for (int db = 0; db < 2; ++db) st[db] = splat16(0.f);
    const int krow = 16 * w + (lane >> 4);
    const bf16* kg0 = RKT + ((size_t)(b * 4 + hr) * NCHUNK * 128 + krow) * 128;
    LAS unsigned char* kd = lds + w * 4096;
    const bf16* vtb = RVT + (size_t)(b * 4 + hr) * NCHUNK * 256 * 128;
    const unsigned vlo = (unsigned)(((32 * es + r) * 128 + 8 * hh) * 2);
    bf16* sto = ST + ((size_t)((b * 4 + hr) * NCHUNK)) * 32768 + ((es * 16 + 2 * hh) * 32 + r) * 8;
    bf16x8 vX[8], vY[8], vZ[8];
#define SC_DMA(c, stg) do { _Pragma("unroll") for (int i = 0; i < 4; ++i) GLDS16NT(kg0 + (size_t)(c) * 16384 + i * 512 + (((lane & 15) ^ (((lane >> 4) << 2) | i)) << 3), kd + ((stg) & 3) * SC_STG + i * 1024); } while (0)
#define SC_VLD(dst, c, s_) do { const bf16* pb_ = vtb + (size_t)(c) * 32768 + 16 * (s_); asm volatile("global_load_dwordx4 %0, %1, %2" : "=v"(dst) : "v"(vlo), "s"(pb_) : "memory"); } while (0)
#define SC_VWAIT(V_, N) asm volatile("s_waitcnt vmcnt(" #N ")" : "+v"(V_[0]), "+v"(V_[1]), "+v"(V_[2]), "+v"(V_[3]), "+v"(V_[4]), "+v"(V_[5]), "+v"(V_[6]), "+v"(V_[7]) :: "memory")
    SC_DMA(0, 0);
#pragma unroll
    for (int s_ = 0; s_ < 8; ++s_) SC_VLD(vX[s_], 0, s_);
    SC_DMA(1, 1);
#pragma unroll
    for (int s_ = 0; s_ < 8; ++s_) SC_VLD(vY[s_], 1, s_);
    SC_DMA(2, 2);
#pragma unroll
    for (int s_ = 0; s_ < 8; ++s_) SC_VLD(vZ[s_], 2, s_);
    SC_VWAIT(vX, 0); SC_VWAIT(vY, 0); SC_VWAIT(vZ, 0);
    __builtin_amdgcn_s_barrier(); asm volatile("" ::: "memory");
#define SC_STEP(n_, Vc) { \
        _Pragma("unroll") for (int db = 0; db < 2; ++db) { *(bf16x8*)(sto + (size_t)(n_) * 32768 + (4 * (2 * dg + db)) * 256) = pack8<0>(st[db]); *(bf16x8*)(sto + (size_t)(n_) * 32768 + (4 * (2 * dg + db) + 1) * 256) = pack8<8>(st[db]); } \
        if ((n_) == NCHUNK - 1) break; \
        const int c3_ = ((n_) + 3 < NCHUNK - 1) ? (n_) + 3 : NCHUNK - 2;     \
        asm volatile("" ::: "memory"); \
        SC_DMA(c3_, (n_) + 3); \
        SC_VWAIT(Vc, 40);                                                  \
        const LAS unsigned char* ka = lds + ((n_) & 3) * SC_STG; \
        _Pragma("unroll") for (int db = 0; db < 2; ++db) st[db] = st[db] * dec; \
        _Pragma("unroll") for (int s_ = 0; s_ < 8; ++s_) { \
            _Pragma("unroll") for (int db = 0; db < 2; ++db) { const s16x4 lo_ = __builtin_amdgcn_ds_read_tr16_b64_v4i16((LAS s16x4*)(ka + aoff[db][0] + 4096 * s_)), hi_ = __builtin_amdgcn_ds_read_tr16_b64_v4i16((LAS s16x4*)(ka + aoff[db][1] + 4096 * s_)); \
                st[db] = MFMA32(((bf16x8){lo_[0], lo_[1], lo_[2], lo_[3], hi_[0], hi_[1], hi_[2], hi_[3]}), Vc[s_], st[db]); } \
            SC_VLD(Vc[s_], c3_, s_); } \
          \
        asm volatile("s_waitcnt vmcnt(40) lgkmcnt(0)" ::: "memory"); \
        __builtin_amdgcn_s_barrier(); asm volatile("" ::: "memory"); }
    for (int n = 0; ; n += 3) {
        SC_STEP(n, vX)
        SC_STEP(n + 1, vY)
        SC_STEP(n + 2, vZ)
    }
#undef SC_STEP
#undef SC_VWAIT
#undef SC_VLD
#undef SC_DMA
    asm volatile("s_waitcnt vmcnt(0) lgkmcnt(0)" ::: "memory"); __builtin_amdgcn_s_barrier(); asm volatile("" ::: "memory");
}

constexpr int RC_SLOT = 32768;
__device__ __forceinline__ void retc_units(LAS unsigned char* lds, LAS float* xch, const bf16* RQ, const bf16* RK, const bf16* RVT, const bf16* ST, const bf16* RG, bf16* YAB, int u0, int nu, int w, int lane) {
    const int r = lane & 31, hh = lane >> 5, ib = w >> 1, eh = w & 1, x7 = r & 7, il = 32 * ib + r, rv = vrow(r), v7 = rv & 7;
    const int prow = 16 * w + (lane >> 4);
    const int NG = 5 * nu;
#define RC_ISSUE(UI, K) do { const int u_ = u0 + (UI), bh_ = u_ >> 5, n_ = u_ & 31; LAS unsigned char* d_ = lds + ((5 * (UI) + (K)) & 3) * RC_SLOT + w * 4096; \
        _Pragma("unroll") for (int i_ = 0; i_ < 4; ++i_) { const int row_ = prow + 4 * i_; const int co_ = (((lane & 15) ^ (row_ & 7)) << 3); const bf16* src_; \
            if ((K) == 0) src_ = RK + ((size_t)bh_ * SEQ + n_ * 128 + row_) * 128 + co_; \
            else if ((K) & 1) { const int p_ = 4 * w + i_, e_ = 64 * ((K) - 1) + 64 * (p_ & 1) + lane; src_ = ST + (size_t)(bh_ * NCHUNK + n_) * 32768 + (((e_ >> 5) * 16 + (p_ >> 1)) * 32 + (e_ & 31)) * 8; }     \
            else src_ = RVT + ((size_t)(bh_ * NCHUNK + n_) * 256 + 64 * ((K) - 2) + row_) * 128 + co_; \
            GLDS16NT(src_, d_ + i_ * 1024); } } while (0)
#define RC_W(N) asm volatile("s_waitcnt vmcnt(" #N ") lgkmcnt(0)" ::: "memory")
#define RC_STEP(UI, K) do { const int g_ = 5 * (UI) + (K); const bool first_ = (UI) == 0, lastu_ = (UI) == nu - 1; \
        if ((K) < 2) { if (first_) RC_W(16); else RC_W(24); } else if ((K) == 2) { if (first_) RC_W(24); else RC_W(32); } \
        else if ((K) == 3) { if (lastu_) RC_W(12); else RC_W(16); } else { if (lastu_) RC_W(8); else RC_W(16); } \
        __builtin_amdgcn_s_barrier(); asm volatile("" ::: "memory"); \
        if (g_ + 3 < NG) { if ((K) < 2) RC_ISSUE((UI), (K) + 3); else RC_ISSUE((UI) + 1, (K) - 2); } } while (0)
#define RC_SB(UI, K) (lds + ((5 * (UI) + (K)) & 3) * RC_SLOT)
#define RC_CROSS(SB, A0) do { _Pragma("unroll") for (int e2 = 0; e2 < 2; ++e2) { f32x16 c_ = splat16(0.f); const LAS unsigned char* sa_ = (SB) + (64 * eh + 32 * e2 + rv) * 16 + hh * 2048; \
            _Pragma("unroll") for (int s = 0; s < 8; ++s) c_ = MFMA32(*(const LAS bf16x8*)(sa_ + s * 4096), qf[s], c_); \
            acc[(A0) + e2] = c_ * qd; } } while (0)
#define RC_INNER(SB, A0) do { _Pragma("unroll") for (int e2 = 0; e2 < 2; ++e2) { const LAS unsigned char* va_ = (SB) + (64 * eh + 32 * e2 + rv) * 256; \
            _Pragma("unroll") for (int jb = 0; jb < 4; ++jb) if (jb <= ib) { \
                _Pragma("unroll") for (int s2 = 0; s2 < 2; ++s2) { const int ch_ = 4 * jb + 2 * hh + s2; \
                    acc[(A0) + e2] = MFMA32(*(const LAS bf16x8*)(va_ + ((ch_ ^ v7) << 4)), pb[jb][s2], acc[(A0) + e2]); } } } } while (0)
    RC_ISSUE(0, 0); RC_ISSUE(0, 1); RC_ISSUE(0, 2);
    for (int ui = 0; ui < nu; ++ui) {
        const int u = u0 + ui, bh = u >> 5, n = u & 31, hr = bh & 3;
        const float lg = pg8::lg2gamma(hr), qd = __builtin_amdgcn_exp2f((float)(il + 1) * lg);
        const size_t trow = (size_t)(bh >> 2) * SEQ + n * 128 + il;
        bf16x8 qf[8]; bf16x8 pb[4][2]; f32x16 acc[4];
#pragma unroll
        for (int s = 0; s < 8; ++s) qf[s] = ld16(RQ + ((size_t)bh * SEQ + n * 128 + il) * 128 + 16 * s + 8 * hh);
        RC_STEP(ui, 0);
#pragma unroll
        for (int jb = 0; jb < 4; ++jb) if (jb <= ib) {
            f32x16 sT = splat16(0.f);
            const LAS unsigned char* ka = RC_SB(ui, 0) + (32 * jb + rv) * 256;
#pragma unroll
            for (int s = 0; s < 8; ++s) sT = MFMA32(*(const LAS bf16x8*)(ka + (((2 * s + hh) ^ v7) << 4)), qf[s], sT);
            int ilo = il; asm volatile("" : "+v"(ilo));
#pragma unroll
            for (int rg = 0; rg < 16; ++rg) { const int diff = ilo - (32 * jb + 16 * hh + rg); sT[rg] = diff >= 0 ? sT[rg] * __builtin_amdgcn_exp2f((float)diff * lg) : 0.f; }
            pb[jb][0] = pack8<0>(sT); pb[jb][1] = pack8<8>(sT);
        } else { pb[jb][0] = pb[jb][1] = (bf16x8){0, 0, 0, 0, 0, 0, 0, 0}; }
        RC_STEP(ui, 1); RC_CROSS(RC_SB(ui, 1), 0);
        const bf16* rgp = RG + trow * 1024 + hr * 256 + 64 * eh + 16 * hh;
        pg8::u32x4 gw[4][2];
#pragma unroll
        for (int a = 0; a < 4; ++a)
#pragma unroll
            for (int hf = 0; hf < 2; ++hf) gw[a][hf] = __builtin_nontemporal_load((const pg8::u32x4*)(rgp + 128 * (a >> 1) + 32 * (a & 1) + 8 * hf));
        RC_STEP(ui, 2); RC_INNER(RC_SB(ui, 2), 0);
        RC_STEP(ui, 3); RC_CROSS(RC_SB(ui, 3), 2);
        RC_STEP(ui, 4); RC_INNER(RC_SB(ui, 4), 2);
        float s1 = 0.f, s2 = 0.f;
#pragma unroll
        for (int a = 0; a < 4; ++a)
#pragma unroll
            for (int rg = 0; rg < 16; ++rg) { s1 += acc[a][rg]; s2 += acc[a][rg] * acc[a][rg]; }
        s1 += __shfl_xor(s1, 32); s2 += __shfl_xor(s2, 32);
        if (hh == 0) { xch[(w * 32 + r) * 2] = s1; xch[(w * 32 + r) * 2 + 1] = s2; }
        asm volatile("s_waitcnt lgkmcnt(0)" ::: "memory"); __builtin_amdgcn_s_barrier(); asm volatile("" ::: "memory");
        s1 += xch[((w ^ 1) * 32 + r) * 2]; s2 += xch[((w ^ 1) * 32 + r) * 2 + 1];
        const float mean = s1 * (1.0f / 256.0f), var = fmaxf(s2 * (1.0f / 256.0f) - mean * mean, 0.f), rstd = 1.0f / sqrtf(var + EPS);
        bf16* yo = YAB + pg8::yab_idx(trow, 512 + hr * 256 + 64 * eh) + 16 * hh;
#pragma unroll
        for (int a = 0; a < 4; ++a)
#pragma unroll
            for (int hf = 0; hf < 2; ++hf) { const f32x4 g0 = pg8::unlo(gw[a][hf]), g1 = pg8::unhi(gw[a][hf]); f32x4 y0, y1;
#pragma unroll
                for (int i = 0; i < 4; ++i) { y0[i] = (acc[a][8 * hf + i] - mean) * rstd * g0[i]; y1[i] = (acc[a][8 * hf + 4 + i] - mean) * rstd * g1[i]; }
                *(pg8::u32x4*)(yo + (a >> 1) * 2 * 16384 + 32 * (a & 1) + 8 * hf) = pg8::pk8(y0, y1); }
    }
#undef RC_ISSUE
#undef RC_STEP
#undef RC_W
#undef RC_SB
#undef RC_CROSS
#undef RC_INNER
    asm volatile("s_waitcnt vmcnt(0) lgkmcnt(0)" ::: "memory"); __builtin_amdgcn_s_barrier(); asm volatile("" ::: "memory");
}

struct Args { const float* in[17]; float* out; unsigned char* ws; };
__global__ void __launch_bounds__(NWAVES * 64, 2) fwd_megakernel(Args args) {
    extern __shared__ __attribute__((aligned(16))) unsigned char lds[];
    LAS unsigned char* ldsp = (LAS unsigned char*)lds;
    const int wave = __builtin_amdgcn_readfirstlane((int)threadIdx.x >> 6);
    const int G = gridDim.x, bx = blockIdx.x, vcu = (G % 8 == 0) ? (bx % 8) * (G / 8) + bx / 8 : bx;
    const int gw = vcu * NWAVES + wave, NGW = G * NWAVES;
    unsigned char* ws = args.ws;
    gu32* ctl = (gu32*)(ws + WS_CTL);
    const float *x = args.in[0], *mem = args.in[1], *norm_mix = args.in[2], *w_in = args.in[3], *w_a = args.in[4], *w_b = args.in[5], *w_out = args.in[6], *norm_cross = args.in[7], *norm_mem = args.in[8],
                *w_xq = args.in[9], *w_xkv = args.in[10], *w_xo = args.in[11], *norm_ffn = args.in[12], *w_gate = args.in[13], *w_up = args.in[14], *w_down = args.in[15], *norm_final = args.in[16];
    float* out = args.out;
    bf16 *WIN = (bf16*)(ws + WS_WIN), *WAB = (bf16*)(ws + WS_WAB), *WOUT = (bf16*)(ws + WS_WOUT), *WXQ = (bf16*)(ws + WS_WXQ), *WXKV = (bf16*)(ws + WS_WXKV), *WXO = (bf16*)(ws + WS_WXO), *WGU = (bf16*)(ws + WS_WGU), *WDN = (bf16*)(ws + WS_WDN);
    bf16 *H = (bf16*)(ws + WS_H), *YAB = (bf16*)(ws + WS_YAB), *AK = (bf16*)(ws + WS_AK), *AVT = (bf16*)(ws + WS_AVT), *RQ = (bf16*)(ws + WS_RQ), *RK = (bf16*)(ws + WS_RK), *RKT = (bf16*)(ws + WS_RKT), *RVT = (bf16*)(ws + WS_RVT), *RG = (bf16*)(ws + WS_RG);
    bf16 *GR = (bf16*)out, *GS = (bf16*)out + (size_t)MTOK * DM;
    bf16 *ST = (bf16*)(ws + WS_ST), *QX = (bf16*)(ws + WS_QX), *MERGED = (bf16*)(ws + WS_MERGED), *OX = (bf16*)(ws + WS_OX), *XB = (bf16*)(ws + WS_XB), *ACT = (bf16*)(ws + WS_ACT);
    bf16 *MEMN = (bf16*)(ws + WS_MEMN), *KX = (bf16*)(ws + WS_KX), *VXT = (bf16*)(ws + WS_VXT);
    float *X1 = (float*)(ws + WS_X1), *SSQ1 = (float*)(ws + WS_SSQ1), *SSQ2 = (float*)(ws + WS_SSQ2), *SSQ3 = (float*)(ws + WS_SSQ3), *KMEAN = (float*)(ws + WS_KMEAN), *T64 = (float*)(ws + WS_T64), *T128 = (float*)(ws + WS_T128);

    for (int u = threadIdx.x; u < (LDS_BYTES - LDSCTL_OFF) / 4; u += NWAVES * 64) ((LAS unsigned*)(ldsp + LDSCTL_OFF))[u] = 0u;
    __syncthreads();
    XcdBarrier bar = xcd_barrier_post((unsigned*)(ctl + CW_BAR), (volatile LAS unsigned*)(ldsp + MISC_OFF) + 8);
#define GRID_BAR() xcd_barrier(bar, wave == 0 && lane_id_v() == 0)
    unsigned long long t_prev = 0ull, t_span = 0ull;
    if (PROBE_PHASE >= 0) t_prev = rt();
#define STAMP(k) do { if (PROBE_PHASE >= 0) { const unsigned long long t_ = rt(); if ((k) == PROBE_PHASE) t_span = t_ - t_prev; t_prev = t_; } } while (0)

    const int sel_items = BATCH * 8 * 15, sel_free = sel_items - ((sel_items + G - 1) / G - 1) * G, nlate = (G - sel_free) < I_KV ? (G - sel_free) : I_KV;
    {
        const int lane = lane_id_v();
        const int tid = wave * 64 + lane;
        for (int it = vcu; it < W_EARLY - nlate; it += G) weight_item(it, w_in, w_a, w_b, w_out, w_xq, w_xo, w_xkv, w_gate, w_up, w_down, norm_cross, norm_ffn, WIN, WAB, WOUT, WXQ, WXO, WXKV, WGU, WDN, ldsp, tid);
        for (int m = gw; m < MTOK; m += 8 * NGW) { if (m + 7 * NGW < MTOK) rms_rows_to_bf16<8>(x, norm_mix, H, m, NGW, lane); else for (int q = m; q < MTOK; q += NGW) rms_row_to_bf16(x + (size_t)q * DM, norm_mix, H + (size_t)q * DM, lane); }
        for (int m = gw; m < MMEM; m += NGW) rms_row_to_bf16(mem + (size_t)m * DM, norm_mem, MEMN + (size_t)m * DM, lane);
        for (int e = gw * 64 + lane; e < SEQ * 96; e += NGW * 64) {
            float c, s;
            if (e < SEQ * 32) { rope_cs(e >> 5, e & 31, 64, c, s); T64[2 * e] = c; T64[2 * e + 1] = s; }
            else { const int e2 = e - SEQ * 32; rope_cs(e2 >> 6, e2 & 63, 128, c, s); T128[2 * e2] = c; T128[2 * e2 + 1] = s; }
        }
    }
    GRID_BAR(); STAMP(0);

    {
        pg8::Gemm g{H, WIN, MTOK, INC, DM}; pg8::StaticOrderMap<0> S; S.base.init(MTOK, INC - 6 * 256, G, bx);
        pg8::EpiProj E{YAB, AK, AVT, RQ, RK, RKT, RVT, RG, GR, GS, KMEAN, T64, T128};
        pg8::gemm_phase<pg8::EpiProj, pg8::StaticOrderMap<0>, true, true>(ldsp + RING_OFF, g, S, E, wave);
        pg8::Gemm gv{WIN, H, INC, MTOK, DM}; pg8::StaticOrderMap<1> SV; SV.base.init(6 * 256, MTOK, G, bx);
        pg8::EpiVT EV{AVT, RVT};
        pg8::gemm_phase<pg8::EpiVT, pg8::StaticOrderMap<1>, true, true>(ldsp + RING_OFF, gv, SV, EV, wave);
    }
    GRID_BAR(); STAMP(1);

    unsigned short* LIST = (unsigned short*)(ws + WS_WIN);
    unsigned* CNTQ = (unsigned*)ctl + CW_CNT;
    bf16* PO0 = (bf16*)out + (size_t)MTOK * DM; float* PML = (float*)((unsigned char*)out + (size_t)MTOK * DM * 2 + 34 * MiB);
    { const int ln = lane_id_v(); for (int it = vcu; it < sel_items; it += G) moba_select_item(ldsp, YAB, KMEAN, LIST, CNTQ, (it & 63) >> 3, it & 7, 1 + (it >> 6), wave, ln);
      if (vcu >= sel_free && vcu - sel_free < nlate) { __syncthreads(); const int l2 = lane_id_v();
          weight_item(W_EARLY - nlate + (vcu - sel_free), w_in, w_a, w_b, w_out, w_xq, w_xo, w_xkv, w_gate, w_up, w_down, norm_cross, norm_ffn, WIN, WAB, WOUT, WXQ, WXO, WXKV, WGU, WDN, ldsp, wave * 64 + l2); } }
    GRID_BAR(); STAMP(12);

    {
        volatile LAS unsigned* qw = (volatile LAS unsigned*)(ldsp + LDSCTL_OFF + 64);
        constexpr unsigned NSCAN = BATCH * 4 * 2, NKVX = 64, NPAST = BATCH * 8 * 8, NWT = W_ITEMS - W_EARLY;
        for (;;) {
            if (wave == 0 && lane_id_v() == 0) *qw = __hip_atomic_fetch_add(ctl + CW_Q, 1u, RLX_AGENT);
            __syncthreads();
            const unsigned idx = (unsigned)__builtin_amdgcn_readfirstlane((int)*qw);
            __syncthreads();
            if (idx >= NSCAN + NKVX + NPAST + NWT) break;
            const int ln = lane_id_v();
            if (idx < NSCAN) { scan_unit(ldsp, RKT, RVT, ST, (int)(idx >> 3), (int)((idx >> 1) & 3), (int)(idx & 1), wave, ln); }
            else if (idx >= NSCAN + NPAST && idx < NSCAN + NPAST + NKVX) { const int k = (int)(idx - NSCAN - NPAST);
                pg8::Gemm g2{MEMN, WXKV, MMEM, 2048, DM}; pg8::OneUnit S2{k >> 3, k & 7}; pg8::EpiKVX E2{KX, VXT};
                pg8::gemm_phase<pg8::EpiKVX, pg8::OneUnit, true, true>(ldsp + RING_OFF, g2, S2, E2, wave); }
            else if (idx < NSCAN + NPAST) { const unsigned k = idx - NSCAN; const int p = (int)(k >> 6), rem = (int)(k & 63);
                moba_past_unit(ldsp, YAB, AK, AVT, LIST, CNTQ, PO0, PML, rem >> 3, rem & 7, p, p < 7 ? 14 - p : -1, wave, ln); }
            else weight_item((int)(idx - (NSCAN + NKVX + NPAST)) + W_EARLY, w_in, w_a, w_b, w_out, w_xq, w_xo, w_xkv, w_gate, w_up, w_down, norm_cross, norm_ffn, WIN, WAB, WOUT, WXQ, WXO, WXKV, WGU, WDN, ldsp, wave * 64 + ln);
        }
    }
    GRID_BAR(); STAMP(13);

    { const int per = (BATCH * 8 * 8) / G, ln = lane_id_v(); for (int i = 0; i < per; ++i) { const int u = vcu * per + i; moba_own_pair(ldsp, YAB, AK, AVT, PO0, PML, u >> 6, (u >> 3) & 7, 2 * (u & 7), 2 * (u & 7) + 1, wave, ln); } }
    GRID_BAR(); STAMP(2);

    { const int per = (BATCH * 4 * NCHUNK) / G, ln = lane_id_v(); retc_units(ldsp, (LAS float*)(ldsp + LDSCTL_OFF + 1024), RQ, RK, RVT, ST, RG, YAB, vcu * per, per, wave, ln); }
    GRID_BAR(); STAMP(3);

    {
        pg8::Gemm g{YAB, WAB, MTOK, DM, 1536, 1}; pg8::StaticOrder S; S.init(MTOK, DM, G, bx);
        pg8::EpiMerge E{GR, GS, MERGED};
        pg8::gemm_phase<pg8::EpiMerge, pg8::StaticOrder, true, true>(ldsp + RING_OFF, g, S, E, wave);
    }
    GRID_BAR(); STAMP(4);

    {
        pg8::Gemm g{MERGED, WOUT, MTOK, DM, DM}; pg8::StaticOrder S; S.init(MTOK, DM, G, bx);
        pg8::EpiResid<false, true> E{x, XB, SSQ1};
        pg8::gemm_phase<pg8::EpiResid<false, true>, pg8::StaticOrder, true, true>(ldsp + RING_OFF, g, S, E, wave);
    }
    GRID_BAR(); STAMP(5);

    {
        const int per = (BATCH * 4 * 32) / G, u0 = vcu * per, bh = u0 >> 5;
        pg8::Gemm g{XB, WXQ, MTOK, DM, DM}; pg8::RowRun S{(bh >> 2) * 16 + ((u0 & 31) >> 1), bh & 3, per >> 1};
        pg8::EpiRowScale E{SSQ1, QX, 0.0625f * LOG2E};
        pg8::gemm_phase<pg8::EpiRowScale, pg8::RowRun, true, true>(ldsp + RING_OFF, g, S, E, wave);
        const int ln = lane_id_v();
        xattn_units(ldsp, QX, KX, VXT, OX, u0, per, wave, ln);
    }
    STAMP(6); GRID_BAR(); STAMP(7);

    {
        pg8::Gemm g{OX, WXO, MTOK, DM, DM}; pg8::StaticOrder S; S.init(MTOK, DM, G, bx);
        pg8::EpiResid<true, true> E{XB, XB, SSQ2};
        pg8::gemm_phase<pg8::EpiResid<true, true>, pg8::StaticOrder, true, true>(ldsp + RING_OFF, g, S, E, wave);
    }
    GRID_BAR(); STAMP(8);

    {
        pg8::Gemm g{XB, WGU, MTOK, 2 * DFF, DM}; pg8::StaticOrder S; S.init(MTOK, 2 * DFF, G, bx);
        pg8::EpiSwiGLU E{SSQ2, ACT};
        pg8::gemm_phase<pg8::EpiSwiGLU, pg8::StaticOrder, true, true>(ldsp + RING_OFF, g, S, E, wave);
    }
    GRID_BAR(); STAMP(9);

    {
        pg8::Gemm g{ACT, WDN, MTOK, DM, DFF}; pg8::StaticOrder S; S.init(MTOK, DM, G, bx);
        pg8::EpiResid<true, true> E{XB, XB, SSQ3};
        pg8::gemm_phase<pg8::EpiResid<true, true>, pg8::StaticOrder, true, true>(ldsp + RING_OFF, g, S, E, wave);
    }
    GRID_BAR(); STAMP(10);

    {
        const unsigned bad = (__hip_atomic_load(ctl + CW_TMO, RLX_AGENT) != 0u) | (__hip_atomic_load(ctl + CW_BAR + XB_TMO, RLX_AGENT) != 0u);
        const int lane = lane_id_v();
        const f32x4 nanv = (f32x4){__builtin_nanf(""), __builtin_nanf(""), __builtin_nanf(""), __builtin_nanf("")};
        for (int m = gw; m < MTOK; m += 4 * NGW) {
            if (m + 3 * NGW < MTOK) {
                float rs[4]; unsigned long long w[4][4];
#pragma unroll
                for (int q = 0; q < 4; ++q) { const int mq = m + q * NGW; rs[q] = pg8::row_rstd(SSQ3, mq);
                    const GAS unsigned long long* xr = (const GAS unsigned long long*)(XB + (size_t)mq * DM) + lane;
#pragma unroll
                    for (int j = 0; j < 4; ++j) w[q][j] = xr[64 * j]; }
                const GAS f32x4* gr = (const GAS f32x4*)norm_final + lane;
#pragma unroll
                for (int q = 0; q < 4; ++q) { GAS f32x4* orow = (GAS f32x4*)(out + (size_t)(m + q * NGW) * DM) + lane;
#pragma unroll
                    for (int j = 0; j < 4; ++j) { const unsigned lo = (unsigned)w[q][j], hi = (unsigned)(w[q][j] >> 32);
                        f32x4 v = (f32x4){pg8::bflo(lo), pg8::bfhi(lo), pg8::bflo(hi), pg8::bfhi(hi)} * rs[q] * gr[64 * j];
                        if (bad) v = nanv; __builtin_nontemporal_store(v, orow + 64 * j); } }
            } else for (int mq = m; mq < MTOK; mq += NGW) {
                const float rs = pg8::row_rstd(SSQ3, mq);
                const GAS unsigned long long* xr = (const GAS unsigned long long*)(XB + (size_t)mq * DM) + lane; GAS f32x4* orow = (GAS f32x4*)(out + (size_t)mq * DM) + lane; const GAS f32x4* gr = (const GAS f32x4*)norm_final + lane;
#pragma unroll
                for (int j = 0; j < 4; ++j) { const unsigned long long w = __builtin_nontemporal_load(xr + 64 * j); const unsigned lo = (unsigned)w, hi = (unsigned)(w >> 32);
                    f32x4 v = (f32x4){pg8::bflo(lo), pg8::bfhi(lo), pg8::bflo(hi), pg8::bfhi(hi)} * rs * gr[64 * j];
                    if (bad) v = nanv; __builtin_nontemporal_store(v, orow + 64 * j); }
            }
        }
    }
    if (PROBE_PHASE >= 0) { STAMP(11); if (bx == 0 && wave == 0 && lane_id_v() == 0) { const unsigned long long t0_ = rt(); while (rt() - t0_ < t_span) __builtin_amdgcn_s_sleep(8); } }
}

extern "C" void kernel_launch(void* const* d_in, const int* in_sizes, int n_in, void* d_out, int out_size, void* d_ws, size_t ws_size, hipStream_t stream) {
    static int grid = 0;
    if (grid == 0) {
        if (n_in != 17 || in_sizes[0] != MTOK * DM || out_size != MTOK * DM || ws_size < WS_END) { fprintf(stderr, "kernel_launch: unexpected shapes (n_in %d, in0 %d, out %d, ws %zu); nothing launched\n", n_in, n_in > 0 ? in_sizes[0] : -1, out_size, ws_size); grid = -1; return; }
        int dev = 0, cus = 0, per_cu = 0;
        if (hipGetDevice(&dev) != hipSuccess || hipDeviceGetAttribute(&cus, hipDeviceAttributeMultiprocessorCount, dev) != hipSuccess) { grid = -1; return; }
        if (hipFuncSetAttribute((const void*)fwd_megakernel, hipFuncAttributeMaxDynamicSharedMemorySize, LDS_BYTES) != hipSuccess) { fprintf(stderr, "kernel_launch: hipFuncSetAttribute failed\n"); grid = -1; return; }
        if (hipOccupancyMaxActiveBlocksPerMultiprocessor(&per_cu, (const void*)fwd_megakernel, NWAVES * 64, LDS_BYTES) != hipSuccess || per_cu < 1) { fprintf(stderr, "kernel_launch: occupancy query says %d blocks per CU; nothing launched\n", per_cu); (void)hipGetLastError(); grid = -1; return; }
        grid = cus;
    }
    if (grid < 0) return;
    if (hipMemsetAsync((char*)d_ws + WS_CTL, 0, CTL_ZERO_BYTES, stream) != hipSuccess) { fprintf(stderr, "kernel_launch: hipMemsetAsync failed\n"); return; }
    Args a{};
    for (int i = 0; i < 17; ++i) a.in[i] = (const float*)d_in[i];
    a.out = (float*)d_out; a.ws = (unsigned char*)d_ws;
    void* kargs[] = {&a};
    const hipError_t le = hipLaunchCooperativeKernel((const void*)fwd_megakernel, dim3(grid), dim3(NWAVES * 64), kargs, LDS_BYTES, stream);
    if (le != hipSuccess) fprintf(stderr, "kernel_launch: cooperative launch failed: %s (grid %d)\n", hipGetErrorName(le), grid);
}
```
